# Optimizing an MI355X kernel written in HIP

```python
import jax, jax.numpy as jnp
from jax import lax
import numpy as np

D_MODEL = 1024
BATCH = 8
SEQ = 4096
DEPTH = 4

N_HEADS = 16
HEAD_DIM = D_MODEL // N_HEADS
D_FF = 2816
CONV_WIDTH = 3
Q_BLOCK = 128
NORM_EPS = 1e-6
ATTN_SCALE = HEAD_DIM ** -0.5
N_MIXERS = 2
N_FOX = (DEPTH + 1) // 2
N_SB = DEPTH // 2

kernel_name = "hybrid_fox_stickbreaking_convffn"


def rms_norm(x, g):
    xf = x.astype(jnp.float32)
    y = xf * lax.rsqrt(jnp.mean(xf * xf, axis=-1, keepdims=True) + NORM_EPS)
    return (y * g.astype(jnp.float32)).astype(x.dtype)


def split_heads(t):
    b, s, _ = t.shape
    return t.reshape(b, s, N_HEADS, HEAD_DIM).transpose(0, 2, 1, 3)


def merge_heads(t):
    b, h, s, dh = t.shape
    return t.transpose(0, 2, 1, 3).reshape(b, s, h * dh)


def sweep_query_blocks(block_fn, n_blocks, b, s):
    out = lax.map(block_fn, jnp.arange(n_blocks))
    return out.transpose(1, 2, 0, 3, 4).reshape(b, N_HEADS, s, HEAD_DIM)


def fox_mixer(xn, w_qkvf, b_f, w_o):
    b, s, _ = xn.shape
    proj = xn @ w_qkvf
    q = split_heads(proj[..., :D_MODEL]).astype(jnp.float32)
    k = split_heads(proj[..., D_MODEL:2 * D_MODEL]).astype(jnp.float32)
    v = split_heads(proj[..., 2 * D_MODEL:3 * D_MODEL]).astype(jnp.float32)
    f_logit = (proj[..., 3 * D_MODEL:] + b_f).astype(jnp.float32)
    c = jnp.cumsum(jax.nn.log_sigmoid(f_logit), axis=1).transpose(0, 2, 1)
    key_pos = jnp.arange(s)

    def block(i):
        start = i * Q_BLOCK
        qb = lax.dynamic_slice_in_dim(q, start, Q_BLOCK, axis=2)
        cq = lax.dynamic_slice_in_dim(c, start, Q_BLOCK, axis=2)
        q_pos = start + jnp.arange(Q_BLOCK)
        logits = (jnp.einsum('bhqd,bhkd->bhqk', qb, k) * ATTN_SCALE
                  + cq[..., :, None] - c[..., None, :])
        mask = key_pos[None, :] <= q_pos[:, None]
        logits = jnp.where(mask, logits, -jnp.inf)
        p = jax.nn.softmax(logits, axis=-1)
        return jnp.einsum('bhqk,bhkd->bhqd', p, v)

    o = sweep_query_blocks(block, s // Q_BLOCK, b, s)
    return merge_heads(o).astype(xn.dtype) @ w_o


def stick_breaking_mixer(xn, w_qkv, w_o):
    b, s, _ = xn.shape
    proj = xn @ w_qkv
    q = split_heads(proj[..., :D_MODEL]).astype(jnp.float32)
    k = split_heads(proj[..., D_MODEL:2 * D_MODEL]).astype(jnp.float32)
    v = split_heads(proj[..., 2 * D_MODEL:]).astype(jnp.float32)
    key_pos = jnp.arange(s)

    def block(i):
        start = i * Q_BLOCK
        qb = lax.dynamic_slice_in_dim(q, start, Q_BLOCK, axis=2)
        q_pos = start + jnp.arange(Q_BLOCK)
        z = jnp.einsum('bhqd,bhkd->bhqk', qb, k) * ATTN_SCALE
        mask = key_pos[None, :] < q_pos[:, None]
        log_not_beta = jnp.where(mask, jax.nn.log_sigmoid(-z), 0.0)
        tail = lax.cumsum(log_not_beta, axis=3, reverse=True) - log_not_beta
        log_a = jax.nn.log_sigmoid(z) + tail
        a = jnp.where(mask, jnp.exp(log_a), 0.0)
        return jnp.einsum('bhqk,bhkd->bhqd', a, v)

    o = sweep_query_blocks(block, s // Q_BLOCK, b, s)
    return merge_heads(o).astype(xn.dtype) @ w_o


def conv_ffn(xn, w_up, w_conv, b_conv, w_down):
    s = xn.shape[1]
    h = xn @ w_up
    h_pad = jnp.pad(h, ((0, 0), (CONV_WIDTH - 1, 0), (0, 0)))
    hc = b_conv + sum(w_conv[j] * h_pad[:, j:j + s, :] for j in range(CONV_WIDTH))
    u, g = hc[..., :D_FF], hc[..., D_FF:]
    return (jax.nn.silu(g) * u) @ w_down


def setup_inputs(seed: int = 0) -> dict:
    key = jax.random.key(seed)
    ks = jax.random.split(key, 16)
    f32 = jnp.float32
    d, h, f = D_MODEL, N_HEADS, D_FF
    x = jax.random.normal(ks[0], (BATCH, SEQ, d), f32)
    attn_norm = 1.0 + 0.02 * jax.random.normal(ks[1], (DEPTH, d), f32)
    ffn_norm = 1.0 + 0.02 * jax.random.normal(ks[2], (DEPTH, d), f32)
    final_norm = 1.0 + 0.02 * jax.random.normal(ks[3], (d,), f32)
    fox_w_qkvf = jax.random.normal(ks[4], (N_FOX, d, 3 * d + h), f32) * d ** -0.5
    fox_b_f = 3.0 + 0.5 * jax.random.normal(ks[5], (N_FOX, h), f32)
    fox_w_o = jax.random.normal(ks[6], (N_FOX, d, d), f32) * d ** -0.5
    sb_w_qkv = jax.random.normal(ks[7], (N_SB, d, 3 * d), f32) * d ** -0.5
    sb_w_o = jax.random.normal(ks[8], (N_SB, d, d), f32) * d ** -0.5
    ffn_w_up = jax.random.normal(ks[9], (DEPTH, d, 2 * f), f32) * d ** -0.5
    ffn_w_conv = jax.random.normal(ks[10], (DEPTH, CONV_WIDTH, 2 * f), f32) * CONV_WIDTH ** -0.5
    ffn_b_conv = 0.01 * jax.random.normal(ks[11], (DEPTH, 2 * f), f32)
    ffn_w_down = jax.random.normal(ks[12], (DEPTH, f, d), f32) * f ** -0.5
    return {"x": x, "attn_norm": attn_norm, "ffn_norm": ffn_norm, "final_norm": final_norm,
            "fox_w_qkvf": fox_w_qkvf, "fox_b_f": fox_b_f, "fox_w_o": fox_w_o,
            "sb_w_qkv": sb_w_qkv, "sb_w_o": sb_w_o,
            "ffn_w_up": ffn_w_up, "ffn_w_conv": ffn_w_conv, "ffn_b_conv": ffn_b_conv,
            "ffn_w_down": ffn_w_down}


def reference(x, attn_norm, ffn_norm, final_norm, fox_w_qkvf, fox_b_f, fox_w_o,
              sb_w_qkv, sb_w_o, ffn_w_up, ffn_w_conv, ffn_b_conv, ffn_w_down):
    hs = x
    for i in range(DEPTH):
        xn = rms_norm(hs, attn_norm[i])
        if i % N_MIXERS == 0:
            j = i // N_MIXERS
            hs = hs + fox_mixer(xn, fox_w_qkvf[j], fox_b_f[j], fox_w_o[j])
        else:
            j = i // N_MIXERS
            hs = hs + stick_breaking_mixer(xn, sb_w_qkv[j], sb_w_o[j])
        xn = rms_norm(hs, ffn_norm[i])
        hs = hs + conv_ffn(xn, ffn_w_up[i], ffn_w_conv[i], ffn_b_conv[i], ffn_w_down[i])
    return rms_norm(hs, final_norm)
```

```cpp
#include <hip/hip_runtime.h>
#include <hip/hip_cooperative_groups.h>
#include <cstdio>
#include <cstdint>
namespace cg = cooperative_groups;
namespace pg8 {
#define PG8_LAS __attribute__((address_space(3)))
typedef unsigned short bf16_t;
typedef short bf16x8 __attribute__((ext_vector_type(8)));
typedef float f32x4 __attribute__((ext_vector_type(4)));
typedef unsigned u32x4 __attribute__((ext_vector_type(4)));
constexpr int BM = 256, BK = 64, HALF = 128, HTB = HALF * BK * 2  , STAGE_BYTES = 8 * HTB, NXCD = 8, WGM = 8;

__host__ __device__ __forceinline__ int lds_byte(int r, int c) { const int st = (r >> 4) * 2 + (c >> 5), rr = r & 15, cc = c & 31, ob = rr * 64 + cc * 2; return st * 1024 + (ob ^ (((ob >> 9) & 1) << 5)); }
__host__ __device__ __forceinline__ void stage_rc(int b, int& R, int& C) { const int st = b / 1024, sb = b % 1024, swz = sb ^ (((sb >> 9) & 1) << 5); R = (st >> 1) * 16 + swz / 64; C = (st & 1) * 32 + (swz % 64) / 2; }
__host__ __device__ __forceinline__ int perm32(int rho) { const int n = rho >> 4, i = rho & 15; return 8 * (i >> 2) + 4 * n + (i & 3); }

struct Unit { int pm, pn; };
struct Gemm { const bf16_t* A; const bf16_t* Bt; int M, N, K; };

struct StaticOrder {
    int nM, nN, nwg, G, c;
    __host__ __device__ void init(int M, int N, int G_, int c_) { nM = M / BM; nN = N / BM; nwg = nM * nN; G = G_; c = c_; }
    __host__ __device__ bool next(int i, Unit& u) const {
        const long L = (long)i * G + c; if (L >= nwg) return false;
        int wgid = (int)L; { const int q = nwg / NXCD, r = nwg % NXCD, xcd = wgid % NXCD, off = wgid / NXCD; wgid = (xcd < r ? xcd * (q + 1) : r * (q + 1) + (xcd - r) * q) + off; }
        const int nig = WGM * nN, gid = wgid / nig, fm = gid * WGM, gsz = (nM - fm) < WGM ? (nM - fm) : WGM;
        u.pm = fm + ((wgid % nig) % gsz); u.pn = (wgid % nig) / gsz; return true;
    }
    __device__ __forceinline__ void a_ready(const Unit&) const {}
    __device__ __forceinline__ void done(const Unit&) const {}
};

__device__ __forceinline__ unsigned cvt_pk_bf16(float lo, float hi) { unsigned r; asm volatile("v_cvt_pk_bf16_f32 %0, %1, %2" : "=v"(r) : "v"(lo), "v"(hi)); return r; }
typedef float f32x2 __attribute__((ext_vector_type(2)));
__device__ __forceinline__ f32x2 gelu_pk(f32x2 v) {
    const f32x2 av = __builtin_elementwise_abs(v), d = av * 0.2316418882f + 1.0f;
    f32x2 t; t.x = __builtin_amdgcn_rcpf(d.x); t.y = __builtin_amdgcn_rcpf(d.y);
    f32x2 q = t * 0.5307027145f + (-0.7265760135f); q = q * t + 0.7107068705f; q = q * t + (-0.142248368f); q = q * t + 0.127414796f; q = q * t;
    const f32x2 s = (v * v) * (-0.72134752044f);
    f32x2 e; e.x = __builtin_amdgcn_exp2f(s.x); e.y = __builtin_amdgcn_exp2f(s.y);
    const f32x2 m = v * (q * e), r = v - m;
    f32x2 o; o.x = v.x < 0.f ? m.x : r.x; o.y = v.y < 0.f ? m.y : r.y; return o;
}

template <int ACT  > struct EpiBf16 {
    static constexpr bool PERM = true, AFTER_DRAIN = false; static_assert(ACT == 0 || ACT == 1, "EpiBf16: ACT is 0 (none) or 1 (gelu_pk)");
    bf16_t* O; int ldc; const float* bias; int split_cols; size_t split_stride; float scale0;
    __device__ __forceinline__ void operator()(const f32x4 (&acc)[2][2][4][2], const Unit& u, int wr, int wc, int fr, int fq) const {
        const int row0 = u.pm * BM + wr * 64 + fr; int colt = u.pn * BM; bf16_t* base = O;
        float sc = 1.f; if (split_cols) { const int t = colt / split_cols; base += (size_t)t * split_stride; colt -= t * split_cols; if (t == 0) sc = scale0; }
        const int col0 = colt + wc * 32 + 8 * fq, bcol0 = u.pn * BM + wc * 32 + 8 * fq;
        f32x4 bv[2][2];
#pragma unroll
        for (int bj = 0; bj < 2; ++bj)
#pragma unroll
            for (int n = 0; n < 2; ++n) bv[bj][n] = bias ? *(const f32x4*)(bias + bcol0 + bj * HALF + 4 * n) : (f32x4){0.f, 0.f, 0.f, 0.f};
#pragma unroll
        for (int ai = 0; ai < 2; ++ai)
#pragma unroll
            for (int m = 0; m < 4; ++m) { bf16_t* rowp = base + (size_t)(row0 + ai * HALF + m * 16) * ldc + col0;
#pragma unroll
                for (int bj = 0; bj < 2; ++bj) { f32x4 v0 = acc[ai][bj][m][0] + bv[bj][0], v1 = acc[ai][bj][m][1] + bv[bj][1];
                    if (ACT == 1) { f32x2 a = gelu_pk((f32x2){v0[0], v0[1]}), b = gelu_pk((f32x2){v0[2], v0[3]}), c = gelu_pk((f32x2){v1[0], v1[1]}), d = gelu_pk((f32x2){v1[2], v1[3]});
                        v0 = (f32x4){a.x, a.y, b.x, b.y}; v1 = (f32x4){c.x, c.y, d.x, d.y}; }
                    v0 = v0 * sc; v1 = v1 * sc; u32x4 w; w.x = cvt_pk_bf16(v0[0], v0[1]); w.y = cvt_pk_bf16(v0[2], v0[3]); w.z = cvt_pk_bf16(v1[0], v1[1]); w.w = cvt_pk_bf16(v1[2], v1[3]);
                    *(u32x4*)(rowp + bj * HALF) = w; } }
    }
};
template <class Epi, class Sched, bool ALIGN_EPI = false, bool SP2 = false>
__device__ __forceinline__ void gemm_phase(PG8_LAS unsigned char* lds, const Gemm g, const Sched& S, const Epi& E) {
    int tid_ = threadIdx.x; asm volatile("" : "+v"(tid_));
    const int tid = tid_, wid = __builtin_amdgcn_readfirstlane(tid >> 6), lane = tid & 63, wr = wid >> 2, wc = wid & 3, fr = lane & 15, fq = lane >> 4;
    const int K = g.K, nt = K / BK;
    unsigned voffA[2], voffB[2];
#pragma unroll
    for (int i = 0; i < 2; ++i) { int R, C; stage_rc(tid * 16 + i * 8192, R, C); const int Rb = Epi::PERM ? ((R & ~31) + perm32(R & 31)) : R;
        voffA[i] = (unsigned)(R * K + C) * 2u; voffB[i] = (unsigned)(Rb * K + C) * 2u; }
    const size_t kstep = (size_t)(BK * 2);
    const size_t hstep = (size_t)HALF * K * 2;
    const size_t tstep = 2 * hstep;
    const unsigned ldsw = (unsigned)wid * 1024u;
    const int aoff = lds_byte(wr * 64 + fr, fq * 8), boff = lds_byte(wc * 32 + fr, fq * 8);
#define PG8_SA(b, h) (((b) * 2 + (h)) * HTB)
#define PG8_SB(b, h) ((4 + (b) * 2 + (h)) * HTB)
#define PG8_STAGE(bufoff, gbase, voff) do { _Pragma("unroll") for (int _i = 0; _i < 2; ++_i) \
        __builtin_amdgcn_global_load_lds((const unsigned*)((const char*)(gbase) + (voff)[_i]), (PG8_LAS unsigned*)(lds + (bufoff) + ldsw + _i * 8192), 16, 0, 0); } while (0)
#define PG8_LDA(dst, b, h) do { _Pragma("unroll") for (int m = 0; m < 4; ++m) _Pragma("unroll") for (int k = 0; k < 2; ++k) dst[m][k] = *(const PG8_LAS bf16x8*)(lds + PG8_SA(b, h) + aoff + m * 2048 + k * 1024); } while (0)
#define PG8_LDB(dst, b, h) do { _Pragma("unroll") for (int n = 0; n < 2; ++n) _Pragma("unroll") for (int k = 0; k < 2; ++k) dst[n][k] = *(const PG8_LAS bf16x8*)(lds + PG8_SB(b, h) + boff + n * 2048 + k * 1024); } while (0)
#define PG8_MMA(ai, bj, At, Bt) do { __builtin_amdgcn_s_setprio(1); _Pragma("unroll") for (int m = 0; m < 4; ++m) _Pragma("unroll") for (int n = 0; n < 2; ++n) _Pragma("unroll") for (int k = 0; k < 2; ++k) \
        acc[ai][bj][m][n] = __builtin_amdgcn_mfma_f32_16x16x32_bf16(Bt[n][k], At[m][k], acc[ai][bj][m][n], 0, 0, 0); __builtin_amdgcn_s_setprio(0); } while (0)
#define PG8_WAIT_V(n) asm volatile("s_waitcnt vmcnt(" #n ")" ::: "memory")
#define PG8_WAIT_L(n) asm volatile("s_waitcnt lgkmcnt(" #n ")" ::: "memory")
#define PG8_BAR __builtin_amdgcn_s_barrier()
#define PG8_SCHED __builtin_amdgcn_sched_barrier(0)
    Unit cur, nxt; int ui = 0;
    if (!S.next(0, cur)) return;
    f32x4 acc[2][2][4][2];
#pragma unroll
    for (int a = 0; a < 2; ++a)
#pragma unroll
        for (int b = 0; b < 2; ++b)
#pragma unroll
            for (int m = 0; m < 4; ++m)
#pragma unroll
                for (int n = 0; n < 2; ++n) acc[a][b][m][n] = (f32x4){0.f, 0.f, 0.f, 0.f};
    bf16x8 At[4][2], B0[2][2], B1[2][2];
    const char* cA = (const char*)g.A + (size_t)cur.pm * tstep; const char* cB = (const char*)g.Bt + (size_t)cur.pn * tstep;
    S.a_ready(cur);
    if constexpr (SP2) {
        PG8_STAGE(PG8_SB(0, 0), cB, voffB); PG8_STAGE(PG8_SB(0, 1), cB + hstep, voffB); PG8_STAGE(PG8_SA(0, 0), cA, voffA); PG8_STAGE(PG8_SA(0, 1), cA + hstep, voffA);
        if (wr == 1) PG8_BAR;
        PG8_WAIT_V(2); PG8_BAR;
        PG8_STAGE(PG8_SB(1, 0), cB + kstep, voffB); PG8_STAGE(PG8_SA(1, 0), cA + kstep, voffA); PG8_STAGE(PG8_SB(1, 1), cB + hstep + kstep, voffB);
        PG8_WAIT_V(6); PG8_BAR;
    } else {
        PG8_STAGE(PG8_SB(0, 0), cB, voffB); PG8_STAGE(PG8_SA(0, 0), cA, voffA); PG8_STAGE(PG8_SB(0, 1), cB + hstep, voffB); PG8_STAGE(PG8_SA(0, 1), cA + hstep, voffA);
        if (wr == 1) PG8_BAR;
        PG8_WAIT_V(4); PG8_BAR;
        PG8_STAGE(PG8_SB(1, 0), cB + kstep, voffB); PG8_STAGE(PG8_SA(1, 0), cA + kstep, voffA); PG8_STAGE(PG8_SB(1, 1), cB + hstep + kstep, voffB);
        PG8_WAIT_V(6); PG8_BAR;
    }
    for (;;) {
        const bool has_next = S.next(ui + 1, nxt);
        const char* nA = has_next ? (const char*)g.A + (size_t)nxt.pm * tstep : cA; const char* nB = has_next ? (const char*)g.Bt + (size_t)nxt.pn * tstep : cB;
        for (int t = 0; t < nt; t += 2) {
            const bool last = (t == nt - 2);
            const char* a1 = cA + (size_t)(t + 1) * kstep;
            const char* a2 = last ? nA : cA + (size_t)(t + 2) * kstep; const char* b2 = last ? nB : cB + (size_t)(t + 2) * kstep;
            const char* a3 = a2 + kstep; const char* b3 = b2 + kstep;
            if (last && has_next) S.a_ready(nxt);
            if constexpr (SP2) {
            PG8_LDB(B0, 0, 0); PG8_LDB(B1, 0, 1); PG8_SCHED; PG8_LDA(At, 0, 0); PG8_STAGE(PG8_SA(1, 1), a1 + hstep, voffA);
            PG8_WAIT_V(8); PG8_WAIT_L(0); PG8_BAR; PG8_MMA(0, 0, At, B0); PG8_MMA(0, 1, At, B1); PG8_BAR; PG8_SCHED;
            PG8_LDA(At, 0, 1); PG8_STAGE(PG8_SB(0, 0), b2, voffB); PG8_STAGE(PG8_SB(0, 1), b2 + hstep, voffB); PG8_STAGE(PG8_SA(0, 0), a2, voffA);
            PG8_WAIT_V(8); PG8_WAIT_L(0); PG8_BAR; PG8_MMA(1, 0, At, B0); PG8_MMA(1, 1, At, B1); PG8_BAR; PG8_SCHED;
            PG8_LDB(B0, 1, 0); PG8_LDB(B1, 1, 1); PG8_SCHED; PG8_LDA(At, 1, 0); PG8_STAGE(PG8_SA(0, 1), a2 + hstep, voffA);
            PG8_WAIT_V(8); PG8_WAIT_L(0); PG8_BAR; PG8_MMA(0, 0, At, B0); PG8_MMA(0, 1, At, B1); PG8_BAR; PG8_SCHED;
            PG8_LDA(At, 1, 1); PG8_STAGE(PG8_SB(1, 0), b3, voffB); PG8_STAGE(PG8_SB(1, 1), b3 + hstep, voffB); PG8_STAGE(PG8_SA(1, 0), a3, voffA);
            PG8_WAIT_V(8); PG8_WAIT_L(0); PG8_BAR; PG8_MMA(1, 0, At, B0); PG8_MMA(1, 1, At, B1); PG8_BAR; PG8_SCHED;
            } else {
            PG8_LDB(B0, 0, 0); PG8_SCHED; PG8_LDA(At, 0, 0); PG8_STAGE(PG8_SA(1, 1), a1 + hstep, voffA);
            PG8_WAIT_L(8); PG8_BAR; PG8_WAIT_L(0); PG8_MMA(0, 0, At, B0); PG8_BAR; PG8_SCHED;
            PG8_LDB(B1, 0, 1); PG8_STAGE(PG8_SB(0, 0), b2, voffB);
            PG8_BAR; PG8_WAIT_L(0); PG8_MMA(0, 1, At, B1); PG8_BAR;
            PG8_LDA(At, 0, 1); PG8_STAGE(PG8_SA(0, 0), a2, voffA);
            PG8_BAR; PG8_WAIT_L(0); PG8_MMA(1, 0, At, B0); PG8_BAR; PG8_SCHED;
            PG8_STAGE(PG8_SB(0, 1), b2 + hstep, voffB);
            PG8_WAIT_V(6); PG8_BAR; PG8_MMA(1, 1, At, B1); PG8_BAR;
            PG8_LDB(B0, 1, 0); PG8_SCHED; PG8_LDA(At, 1, 0); PG8_STAGE(PG8_SA(0, 1), a2 + hstep, voffA);
            PG8_WAIT_L(8); PG8_BAR; PG8_WAIT_L(0); PG8_MMA(0, 0, At, B0); PG8_BAR; PG8_SCHED;
            PG8_LDB(B1, 1, 1); PG8_STAGE(PG8_SB(1, 0), b3, voffB);
            PG8_BAR; PG8_WAIT_L(0); PG8_MMA(0, 1, At, B1); PG8_BAR;
            PG8_LDA(At, 1, 1); PG8_STAGE(PG8_SA(1, 0), a3, voffA);
            PG8_BAR; PG8_WAIT_L(0); PG8_MMA(1, 0, At, B0); PG8_BAR; PG8_SCHED;
            PG8_STAGE(PG8_SB(1, 1), b3 + hstep, voffB);
            PG8_WAIT_V(6); PG8_BAR; PG8_MMA(1, 1, At, B1); PG8_BAR;
            }
        }
        if constexpr (ALIGN_EPI) { if (wr == 0) PG8_BAR; }
        if constexpr (!Epi::AFTER_DRAIN) { E(acc, cur, wr, wc, fr, fq); S.done(cur); }
        if (!has_next) break;
#pragma unroll
        for (int a = 0; a < 2; ++a)
#pragma unroll
            for (int b = 0; b < 2; ++b)
#pragma unroll
                for (int m = 0; m < 4; ++m)
#pragma unroll
                    for (int n = 0; n < 2; ++n) acc[a][b][m][n] = (f32x4){0.f, 0.f, 0.f, 0.f};
        cur = nxt; cA = nA; cB = nB; ++ui;
        if constexpr (ALIGN_EPI) { if (wr == 1) PG8_BAR; }
    }
    PG8_WAIT_V(0);
    if constexpr (!ALIGN_EPI) { if (wr == 0) PG8_BAR; }
    PG8_BAR;
    if constexpr (Epi::AFTER_DRAIN) { E.fused(acc, cur, wr, wc, fr, fq, lds, wid, lane); S.done(cur); }
#undef PG8_SA
#undef PG8_SB
#undef PG8_STAGE
#undef PG8_LDA
#undef PG8_LDB
#undef PG8_MMA
#undef PG8_WAIT_V
#undef PG8_WAIT_L
#undef PG8_BAR
#undef PG8_SCHED
}
}
#ifndef DBG_STAGE
#define DBG_STAGE 0
#endif
#ifndef DBG_SKIP
#define DBG_SKIP 0
#endif
constexpr int BATCH = 8, SEQ = 4096, D = 1024, NH = 16, HD = 64, FF = 2816, FF2 = 2 * FF, DEPTH = 4;
constexpr int M = BATCH * SEQ;
constexpr float NORM_EPS = 1e-6f;
constexpr float LOG2E = 1.4426950408889634f;
constexpr float QSCALE = 0.125f * LOG2E;
constexpr int NWAVES = 8, NTHR = 512;

#define LAS __attribute__((address_space(3)))
typedef unsigned short bf16;
typedef float f32x4 __attribute__((ext_vector_type(4)));
typedef float f32x16 __attribute__((ext_vector_type(16)));
typedef short bf16x8 __attribute__((ext_vector_type(8)));
typedef unsigned u32x4 __attribute__((ext_vector_type(4)));
typedef unsigned u32x2 __attribute__((ext_vector_type(2)));

constexpr size_t MiB = 1u << 20;
constexpr size_t W_LAYER = 25 * MiB;
constexpr size_t WO_QK = 0, WO_V = 4 * MiB, WO_O = 6 * MiB, WO_UP = 8 * MiB, WO_DN = 19 * MiB;
constexpr size_t WS_W = 0;
constexpr size_t WS_FLOG = 100 * MiB;
constexpr size_t WS_C2 = 102 * MiB;
constexpr size_t WS_EDGE = 104 * MiB;
constexpr size_t WS_RAW01 = 110 * MiB;
constexpr size_t WS_XN = 116 * MiB;
constexpr size_t WS_QO = 180 * MiB;
constexpr size_t WS_K = 244 * MiB;
constexpr size_t WS_VT = 308 * MiB;
constexpr size_t WS_ACT = 180 * MiB;
constexpr size_t WS_END = 372 * MiB;
static_assert(WS_ACT + (size_t)M * FF * 2 <= WS_END, "ws map");

constexpr int RING_BYTES = 131072, XCH_OFF = RING_BYTES, MISC_OFF = XCH_OFF + 8192, PTAB_OFF = MISC_OFF + 256, LDS_BYTES = 147456;

typedef float f32x2_t __attribute__((ext_vector_type(2))); typedef __bf16 bf16x2_t __attribute__((ext_vector_type(2)));
__device__ __forceinline__ unsigned cvtpk(float lo, float hi) { f32x2_t v = {lo, hi}; bf16x2_t b = __builtin_convertvector(v, bf16x2_t); return __builtin_bit_cast(unsigned, b); }
__device__ __forceinline__ float wave_sum(float v) {
#pragma unroll
    for (int o = 1; o < 64; o <<= 1) v += __shfl_xor(v, o);
    return v;
}
__device__ __forceinline__ float ex2(float x) { return __builtin_amdgcn_exp2f(x); }
__device__ __forceinline__ float lg2(float x) { return __builtin_amdgcn_logf(x); }
struct EpiResid {
    static constexpr bool PERM = true, AFTER_DRAIN = false;
    const float* base; float* out;
    __device__ __forceinline__ void operator()(const pg8::f32x4 (&acc)[2][2][4][2], const pg8::Unit& u, int wr, int wc, int fr, int fq) const {
        const int row0 = u.pm * 256 + wr * 64 + fr, col0 = u.pn * 256 + wc * 32 + 8 * fq;
#pragma unroll
        for (int ai = 0; ai < 2; ++ai)
#pragma unroll
            for (int m = 0; m < 4; ++m) { const size_t off = (size_t)(row0 + ai * 128 + m * 16) * D + col0;
#pragma unroll
                for (int bj = 0; bj < 2; ++bj) { const f32x4 b0 = *(const f32x4*)(base + off + bj * 128), b1 = *(const f32x4*)(base + off + bj * 128 + 4);
                    *(f32x4*)(out + off + bj * 128) = b0 + acc[ai][bj][m][0]; *(f32x4*)(out + off + bj * 128 + 4) = b1 + acc[ai][bj][m][1]; }
                asm volatile("" ::: "memory"); }
    }
};

__device__ __forceinline__ float dpp_ror1(float v) { return __builtin_bit_cast(float, __builtin_amdgcn_update_dpp(0, __builtin_bit_cast(int, v), 0x121, 0xf, 0xf, false)); }
__device__ __forceinline__ float dpp_ror2(float v) { return __builtin_bit_cast(float, __builtin_amdgcn_update_dpp(0, __builtin_bit_cast(int, v), 0x122, 0xf, 0xf, false)); }

struct EpiConvGate {
    static constexpr bool PERM = true, AFTER_DRAIN = false;
    bf16* act; const float* wconv; const float* bconv; float* edge; float* raw01; LAS float* xch;
    __device__ __forceinline__ void operator()(const pg8::f32x4 (&acc)[2][2][4][2], const pg8::Unit& u, int wr, int wc, int fr, int fq) const {
        const int lc0 = wc * 32 + 8 * fq, ch0 = u.pn * 128 + lc0;
        if (fr >= 14) {
#pragma unroll
            for (int ai = 0; ai < 2; ++ai) { const int q = 2 * ai + wr;
#pragma unroll
                for (int bj = 0; bj < 2; ++bj)
#pragma unroll
                    for (int n = 0; n < 2; ++n) *(LAS f32x4*)(xch + (q * 2 + (fr - 14)) * 256 + bj * 128 + lc0 + 4 * n) = acc[ai][bj][3][n]; }
            if (wr == 1) {
#pragma unroll
                for (int bj = 0; bj < 2; ++bj)
#pragma unroll
                    for (int n = 0; n < 2; ++n) *(f32x4*)(edge + ((size_t)u.pm * 2 + (fr - 14)) * FF2 + bj * FF + ch0 + 4 * n) = acc[1][bj][3][n]; }
        }
        if (wr == 0 && fr < 2) {
#pragma unroll
            for (int bj = 0; bj < 2; ++bj)
#pragma unroll
                for (int n = 0; n < 2; ++n) *(f32x4*)(raw01 + ((size_t)u.pm * 2 + fr) * FF2 + bj * FF + ch0 + 4 * n) = acc[0][bj][0][n];
        }
        asm volatile("s_waitcnt lgkmcnt(0)" ::: "memory"); __builtin_amdgcn_s_barrier(); asm volatile("" ::: "memory");
        const bool f1 = fr >= 1, f2 = fr >= 2;
#pragma unroll
        for (int n = 0; n < 2; ++n) {
            const f32x4 wu0 = *(const f32x4*)(wconv + ch0 + 4 * n), wu1 = *(const f32x4*)(wconv + FF2 + ch0 + 4 * n), wu2 = *(const f32x4*)(wconv + 2 * FF2 + ch0 + 4 * n), bu = *(const f32x4*)(bconv + ch0 + 4 * n);
            const f32x4 wg0 = *(const f32x4*)(wconv + FF + ch0 + 4 * n), wg1 = *(const f32x4*)(wconv + FF2 + FF + ch0 + 4 * n), wg2 = *(const f32x4*)(wconv + 2 * FF2 + FF + ch0 + 4 * n), bg = *(const f32x4*)(bconv + FF + ch0 + 4 * n);
#pragma unroll
            for (int ai = 0; ai < 2; ++ai) {
                const int q = 2 * ai + wr;
                f32x4 pru = (f32x4){0.f, 0.f, 0.f, 0.f}, prg = pru;
                if (q > 0 && fr >= 14) { pru = *(const LAS f32x4*)(xch + ((q - 1) * 2 + (fr - 14)) * 256 + lc0 + 4 * n); prg = *(const LAS f32x4*)(xch + ((q - 1) * 2 + (fr - 14)) * 256 + 128 + lc0 + 4 * n); }
#pragma unroll
                for (int m = 0; m < 4; ++m) {
                    float r4[4];
#pragma unroll
                    for (int j = 0; j < 4; ++j) {
                        const float vu = acc[ai][0][m][n][j], vg = acc[ai][1][m][n][j];
                        const float pu = m > 0 ? acc[ai][0][m > 0 ? m - 1 : 0][n][j] : pru[j];
                        const float pg = m > 0 ? acc[ai][1][m > 0 ? m - 1 : 0][n][j] : prg[j];
                        const float vu1 = dpp_ror1(vu), pu1 = dpp_ror1(pu), vu2 = dpp_ror2(vu), pu2 = dpp_ror2(pu);
                        const float vg1 = dpp_ror1(vg), pg1 = dpp_ror1(pg), vg2 = dpp_ror2(vg), pg2 = dpp_ror2(pg);
                        const float u1 = f1 ? vu1 : pu1, u2 = f2 ? vu2 : pu2;
                        const float g1 = f1 ? vg1 : pg1, g2 = f2 ? vg2 : pg2;
                        const float nb = (DBG_STAGE == 21) ? 0.f : 1.f;
                        const float hu = bu[j] + wu2[j] * vu + nb * (wu1[j] * u1 + wu0[j] * u2);
                        const float hg = bg[j] + wg2[j] * vg + nb * (wg1[j] * g1 + wg0[j] * g2);
                        const float sg = hg * __builtin_amdgcn_rcpf(1.f + ex2(-hg * LOG2E));
                        r4[j] = sg * hu;
                    }
                    const int row = u.pm * 256 + ai * 128 + wr * 64 + m * 16 + fr;
                    u32x2 w; w.x = cvtpk(r4[0], r4[1]); w.y = cvtpk(r4[2], r4[3]);
                    if (!(ai == 0 && m == 0 && wr == 0 && fr < 2)) *(u32x2*)(act + (size_t)row * FF + ch0 + 4 * n) = w;
                    asm volatile("" ::: "memory");
                }
            }
        }
    }
};
constexpr int A_ROWB = 144, A_KBUF = 64 * A_ROWB, A_OFF_K = 0, A_OFF_V = 2 * A_KBUF, A_OFF_C = 4 * A_KBUF, A_OFF_FLAG = A_OFF_C + 512;

__device__ __forceinline__ float lane_partner(float v, int hi) {
    auto rr = __builtin_amdgcn_permlane32_swap(__float_as_uint(v), __float_as_uint(v), false, false);
    return __uint_as_float(hi ? rr[0] : rr[1]);
}

template <int MODE>
__device__ __forceinline__ void attn_unit(int b, int h, int qb, const bf16* Q, const bf16* __restrict__ K, const bf16* __restrict__ VT, const float* __restrict__ C2, bf16* O, LAS unsigned char* lds) {
    int tid_ = threadIdx.x; asm volatile("" : "+v"(tid_));
    const int tid = tid_, lane = tid & 63, r32 = lane & 31, hi = lane >> 5; const int wid = __builtin_amdgcn_readfirstlane(tid >> 6);
    const size_t rowbase = (size_t)b * SEQ; const int q0 = qb * 256; const int NT = (q0 + 256) / 64;
    const int qabs = q0 + wid * 32 + r32;
    const bf16* Qw = Q + (rowbase + qabs) * D + h * 64;
    bf16x8 qr[4];
#pragma unroll
    for (int d0 = 0; d0 < 4; ++d0) qr[d0] = *(const bf16x8*)(Qw + d0 * 16 + hi * 8);
    const int lrow = tid >> 3, lch = tid & 7;
    const bf16* ksrc = K + (rowbase + lrow) * D + h * 64 + lch * 8;
    const bf16* vsrc = VT + (size_t)(h * 64 + lrow) * M + rowbase + lch * 8;
    const float* csrc = C2 + ((size_t)(b * NH + h)) * SEQ + 4 * (tid & 15);
    const int ldst = lrow * A_ROWB + lch * 16;
    const int krow = (r32 & ~12) | ((r32 & 4) << 1) | ((r32 & 8) >> 1);
    const int koff = krow * A_ROWB + hi * 16, voff = r32 * A_ROWB + hi * 16;
    u32x4 kreg, vreg; f32x4 creg = (f32x4){0.f, 0.f, 0.f, 0.f};
#define A_TILE(i) (MODE ? (NT - 1 - (i)) : (i))
#define A_LOAD(t) do { kreg = *(const u32x4*)(ksrc + (size_t)(t) * 64 * D); vreg = *(const u32x4*)(vsrc + (t) * 64); if (MODE == 0 && tid < 16) creg = *(const f32x4*)(csrc + (t) * 64); } while (0)
#define A_WRITE(buf) do { *(LAS u32x4*)(lds + A_OFF_K + (buf) * A_KBUF + ldst) = kreg; *(LAS u32x4*)(lds + A_OFF_V + (buf) * A_KBUF + ldst) = vreg; \
        if (MODE == 0 && tid < 16) *(LAS f32x4*)(lds + A_OFF_C + (buf) * 256 + tid * 16) = (DBG_STAGE == 20) ? creg * 0.f : -creg; } while (0)
    f32x16 o0, o1;
#pragma unroll
    for (int r = 0; r < 16; ++r) { o0[r] = 0.f; o1[r] = 0.f; }
    float mrun = -INFINITY, lrun = 0.f, carry = 0.f;
    A_LOAD(A_TILE(0)); A_WRITE(0); __syncthreads();
    for (int i = 0; i < NT; ++i) {
        const int buf = i & 1, t = A_TILE(i);
        if (i + 1 < NT) A_LOAD(A_TILE(i + 1));
        const LAS unsigned char* kb = lds + A_OFF_K + buf * A_KBUF; const LAS unsigned char* vb = lds + A_OFF_V + buf * A_KBUF;
        f32x16 s0, s1;
        if (MODE == 0) {
            const LAS float* cb = (const LAS float*)(lds + A_OFF_C + buf * 256);
#pragma unroll
            for (int g = 0; g < 2; ++g) {
                const f32x4 a0 = *(const LAS f32x4*)(cb + 16 * g + 8 * hi), a1 = *(const LAS f32x4*)(cb + 16 * g + 8 * hi + 4);
                const f32x4 b0 = *(const LAS f32x4*)(cb + 32 + 16 * g + 8 * hi), b1 = *(const LAS f32x4*)(cb + 32 + 16 * g + 8 * hi + 4);
#pragma unroll
                for (int e = 0; e < 4; ++e) { s0[8 * g + e] = a0[e]; s0[8 * g + 4 + e] = a1[e]; s1[8 * g + e] = b0[e]; s1[8 * g + 4 + e] = b1[e]; }
            }
        } else {
#pragma unroll
            for (int r = 0; r < 16; ++r) { s0[r] = 0.f; s1[r] = 0.f; }
        }
#pragma unroll
        for (int d0 = 0; d0 < 4; ++d0) {
            const bf16x8 k0 = *(const LAS bf16x8*)(kb + koff + d0 * 32), k1 = *(const LAS bf16x8*)(kb + 32 * A_ROWB + koff + d0 * 32);
            s0 = __builtin_amdgcn_mfma_f32_32x32x16_bf16(k0, qr[d0], s0, 0, 0, 0);
            s1 = __builtin_amdgcn_mfma_f32_32x32x16_bf16(k1, qr[d0], s1, 0, 0, 0);
        }
        const bool band = t >= NT - 4;
        const int kbase = t * 64 + 8 * hi;
        if (MODE == 0) {
            if (band) {
#pragma unroll
                for (int r = 0; r < 16; ++r) { const int key = kbase + (r & 7) + 16 * (r >> 3); if (key > qabs) s0[r] = -INFINITY; if (key + 32 > qabs) s1[r] = -INFINITY; }
            }
            float mx = fmaxf(s0[0], s1[0]);
#pragma unroll
            for (int r = 1; r < 16; ++r) mx = fmaxf(mx, fmaxf(s0[r], s1[r]));
            mx = fmaxf(mx, lane_partner(mx, hi));
            const float mnew = fmaxf(mrun, mx), alpha = ex2(mrun - mnew);
            float ls = 0.f;
#pragma unroll
            for (int r = 0; r < 16; ++r) { s0[r] = ex2(s0[r] - mnew); s1[r] = ex2(s1[r] - mnew); ls += s0[r] + s1[r]; }
            lrun = lrun * alpha + ls; mrun = mnew;
#pragma unroll
            for (int r = 0; r < 16; ++r) { o0[r] *= alpha; o1[r] *= alpha; }
        } else {
            f32x16 b0, b1;
#pragma unroll
            for (int r = 0; r < 16; ++r) {
                { const float z = s0[r], sp = fmaxf(z, 0.f) + lg2(1.f + ex2(-fabsf(z))); b0[r] = -sp; s0[r] = z - sp; }
                { const float z = s1[r], sp = fmaxf(z, 0.f) + lg2(1.f + ex2(-fabsf(z))); b1[r] = -sp; s1[r] = z - sp; }
            }
            if (band) {
#pragma unroll
                for (int r = 0; r < 16; ++r) { const int key = kbase + (r & 7) + 16 * (r >> 3);
                    if (key >= qabs) { b0[r] = 0.f; s0[r] = -INFINITY; } if (key + 32 >= qabs) { b1[r] = 0.f; s1[r] = -INFINITY; } }
            }
            float T[4];
#pragma unroll
            for (int a = 0; a < 4; ++a) { float tt = 0.f;
#pragma unroll
                for (int e = 0; e < 8; ++e) tt += (a < 2 ? b0[8 * (a & 1) + e] : b1[8 * (a & 1) + e]);
                T[a] = tt; }
            float U[4], tot[4];
#pragma unroll
            for (int a = 0; a < 4; ++a) { U[a] = lane_partner(T[a], hi); tot[a] = T[a] + U[a]; }
            float later = carry;
#pragma unroll
            for (int a = 3; a >= 0; --a) {
                float run = later + (hi == 0 ? U[a] : 0.f);
#pragma unroll
                for (int e = 7; e >= 0; --e) {
                    if (a < 2) { const float lb = b0[8 * (a & 1) + e]; s0[8 * (a & 1) + e] = ex2(s0[8 * (a & 1) + e] + run); run += lb; }
                    else       { const float lb = b1[8 * (a & 1) + e]; s1[8 * (a & 1) + e] = ex2(s1[8 * (a & 1) + e] + run); run += lb; }
                }
                later += tot[a];
            }
            carry = later;
        }
        bf16x8 P[4];
#pragma unroll
        for (int ii = 0; ii < 4; ++ii) { u32x4 w;
            if (ii < 2) { w.x = cvtpk(s0[8 * ii], s0[8 * ii + 1]); w.y = cvtpk(s0[8 * ii + 2], s0[8 * ii + 3]); w.z = cvtpk(s0[8 * ii + 4], s0[8 * ii + 5]); w.w = cvtpk(s0[8 * ii + 6], s0[8 * ii + 7]); }
            else { const int i2 = ii - 2; w.x = cvtpk(s1[8 * i2], s1[8 * i2 + 1]); w.y = cvtpk(s1[8 * i2 + 2], s1[8 * i2 + 3]); w.z = cvtpk(s1[8 * i2 + 4], s1[8 * i2 + 5]); w.w = cvtpk(s1[8 * i2 + 6], s1[8 * i2 + 7]); }
            P[ii] = __builtin_bit_cast(bf16x8, w); }
#pragma unroll
        for (int ii = 0; ii < 4; ++ii) {
            const bf16x8 v0 = *(const LAS bf16x8*)(vb + voff + ii * 32), v1 = *(const LAS bf16x8*)(vb + 32 * A_ROWB + voff + ii * 32);
            o0 = __builtin_amdgcn_mfma_f32_32x32x16_bf16(v0, P[ii], o0, 0, 0, 0);
            o1 = __builtin_amdgcn_mfma_f32_32x32x16_bf16(v1, P[ii], o1, 0, 0, 0);
        }
        if (i + 1 < NT) A_WRITE(buf ^ 1);
        __syncthreads();
    }
    float inv = 1.f;
    if (MODE == 0) { const float lt = lrun + lane_partner(lrun, hi); inv = 1.f / lt; }
    bf16* Ow = O + (rowbase + qabs) * D + h * 64 + 4 * hi;
#pragma unroll
    for (int g = 0; g < 4; ++g) {
        u32x2 w0, w1;
        w0.x = cvtpk(o0[4 * g] * inv, o0[4 * g + 1] * inv); w0.y = cvtpk(o0[4 * g + 2] * inv, o0[4 * g + 3] * inv);
        w1.x = cvtpk(o1[4 * g] * inv, o1[4 * g + 1] * inv); w1.y = cvtpk(o1[4 * g + 2] * inv, o1[4 * g + 3] * inv);
        *(u32x2*)(Ow + 8 * g) = w0; *(u32x2*)(Ow + 32 + 8 * g) = w1;
    }
#undef A_TILE
#undef A_LOAD
#undef A_WRITE
}

template <int MODE>
__device__ __forceinline__ void attn_phase(int vcu, int G, const bf16* Q, const bf16* K, const bf16* VT, const float* C2, bf16* O, LAS unsigned char* lds) {
    for (int v = vcu; v < 256; v += G) {
        const int bh = v >> 1, s = v & 1;
        for (int i = 0; i < 8; ++i) { const int jj = 2 * (i >> 1) + s; const int qb = (i & 1) ? 15 - jj : jj;
            attn_unit<MODE>(bh / NH, bh % NH, qb, Q, K, VT, C2, O, lds); }
    }
}
struct Args { const float* in[13]; float* out; unsigned char* ws; };

__device__ __forceinline__ void transpose_item(const float* W, int ldw, int k0, int n0, bf16* WT, int K, int drow0, LAS float* scr, int lane) {
#pragma unroll 8
    for (int i = 0; i < 32; ++i) { const int kk = 2 * i + (lane >> 5); scr[kk * 33 + (lane & 31)] = W[(size_t)(k0 + kk) * ldw + n0 + (lane & 31)]; }
    asm volatile("s_waitcnt lgkmcnt(0)" ::: "memory");
    const int c = lane & 7;
#pragma unroll
    for (int j = 0; j < 4; ++j) { const int n = (lane >> 3) + 8 * j; const LAS float* s = scr + (8 * c) * 33 + n;
        u32x4 o; o.x = cvtpk(s[0], s[33]); o.y = cvtpk(s[2 * 33], s[3 * 33]); o.z = cvtpk(s[4 * 33], s[5 * 33]); o.w = cvtpk(s[6 * 33], s[7 * 33]);
        *(u32x4*)(WT + (size_t)(drow0 + n) * K + k0 + 8 * c) = o; }
    asm volatile("s_waitcnt lgkmcnt(0)" ::: "memory");
}

#define PIN(T, i) ((T*)ldptr(lds, (i)))
__device__ __forceinline__ void* ldptr(LAS unsigned char* lds, int i) {
    const u32x2 v = *(const LAS u32x2*)(lds + PTAB_OFF + 8 * i);
    const unsigned long long p = ((unsigned long long)(unsigned)__builtin_amdgcn_readfirstlane((int)v.y) << 32) | (unsigned)__builtin_amdgcn_readfirstlane((int)v.x);
    return (void*)(__attribute__((address_space(1))) char*)p; }
__device__ __forceinline__ void prologue(LAS unsigned char* lds, int gw, int NGW, int wave, int lane) {
    unsigned char* a_ws = PIN(unsigned char, 14);
    LAS float* scr = (LAS float*)(lds + wave * 16384);
    constexpr int I_QKV = 16 * 96, I_O = 16 * 32, I_UP = 16 * 176, I_DN = 44 * 32, I_L = I_QKV + I_O + I_UP + I_DN;
    for (int it = gw; it < DEPTH * I_L; it += NGW) {
        const int l = it / I_L; int r = it % I_L; const int j = l >> 1; const bool fox = !(l & 1);
        bf16* wl = (bf16*)(a_ws + WS_W + (size_t)l * W_LAYER);
        if (r < I_QKV) { const int kb = r / 96, n0 = 32 * (r % 96);
            const float* W = fox ? PIN(const float, 4) + (size_t)j * D * 3088 : PIN(const float, 7) + (size_t)j * D * 3072; const int ldw = fox ? 3088 : 3072;
            if (n0 < 2048) transpose_item(W, ldw, 64 * kb, n0, wl + WO_QK / 2, D, n0, scr, lane);
            else transpose_item(W, ldw, 64 * kb, n0, wl + WO_V / 2, D, n0 - 2048, scr, lane);
            continue; }
        r -= I_QKV;
        if (r < I_O) { const int kb = r / 32, n0 = 32 * (r % 32); const float* W = (fox ? PIN(const float, 6) : PIN(const float, 8)) + (size_t)j * D * D;
            transpose_item(W, D, 64 * kb, n0, wl + WO_O / 2, D, n0, scr, lane); continue; }
        r -= I_O;
        if (r < I_UP) { const int kb = r / 176, c = 32 * (r % 176); const int drow0 = c < FF ? 256 * (c / 128) + (c % 128) : 256 * ((c - FF) / 128) + 128 + ((c - FF) % 128);
            transpose_item(PIN(const float, 9) + (size_t)l * D * FF2, FF2, 64 * kb, c, wl + WO_UP / 2, D, drow0, scr, lane); continue; }
        r -= I_UP;
        { const int kb = r / 32, n0 = 32 * (r % 32); transpose_item(PIN(const float, 12) + (size_t)l * FF * D, D, 64 * kb, n0, wl + WO_DN / 2, FF, n0, scr, lane); }
    }
}

template <bool FOX>
__device__ __forceinline__ void norm_phase(const float* src, const float* gain, bf16* xn, const float* Wf, const float* bfp, float* flog, LAS unsigned char* lds, int vcu, int G) {
    int tid = threadIdx.x; asm volatile("" : "+v"(tid));
    const int lane = tid & 63, gw = vcu * NWAVES + (tid >> 6), NGW = G * NWAVES;
    LAS float* wf = (LAS float*)lds;
    if (FOX) {
        for (int k = tid; k < D; k += NTHR) { const f32x4* p = (const f32x4*)(Wf + (size_t)k * 3088 + 3072);
#pragma unroll
            for (int q = 0; q < 4; ++q) { const f32x4 w = p[q];
#pragma unroll
                for (int e = 0; e < 4; ++e) wf[(4 * q + e) * 1024 + k] = w[e]; } }
        __syncthreads();
    }
    f32x4 g[4];
#pragma unroll
    for (int j = 0; j < 4; ++j) g[j] = ((const f32x4*)gain)[lane + 64 * j];
    for (int m = gw; m < M; m += NGW) {
        const f32x4* xr = (const f32x4*)(src + (size_t)m * D) + lane;
        f32x4 v[4]; float s = 0.f;
#pragma unroll
        for (int j = 0; j < 4; ++j) { v[j] = xr[64 * j]; s += (v[j].x * v[j].x + v[j].y * v[j].y) + (v[j].z * v[j].z + v[j].w * v[j].w); }
        const float rstd = 1.0f / sqrtf(wave_sum(s) * (1.f / D) + NORM_EPS);
        u32x2* o8 = (u32x2*)(xn + (size_t)m * D) + lane;
#pragma unroll
        for (int j = 0; j < 4; ++j) { v[j] = v[j] * rstd * g[j]; u32x2 w; w.x = cvtpk(v[j].x, v[j].y); w.y = cvtpk(v[j].z, v[j].w); o8[64 * j] = w; }
        if (FOX) {
            float mine = 0.f; int lane_l = lane; asm volatile("" : "+v"(lane_l));
#pragma unroll
            for (int hh = 0; hh < 16; ++hh) { float acc = 0.f;
#pragma unroll
                for (int j = 0; j < 4; ++j) { const f32x4 w = *(const LAS f32x4*)(wf + hh * 1024 + 256 * j + 4 * lane); acc += (v[j].x * w.x + v[j].y * w.y) + (v[j].z * w.z + v[j].w * w.w); }
                acc = wave_sum(acc); mine = (lane_l == hh) ? acc : mine; }
            if (lane < 16) { const float x2 = (mine + bfp[lane]) * LOG2E; flog[(size_t)m * 16 + lane] = fminf(x2, 0.f) - lg2(1.f + ex2(-fabsf(x2))); }
        }
    }
    if (FOX) __syncthreads();
}

__device__ __forceinline__ void scan_phase(const float* flog, float* c2, LAS unsigned char* lds, int G) {
    int tid = threadIdx.x; asm volatile("" : "+v"(tid));
    const int lane = tid & 63, wave = tid >> 6;
    LAS float* wsum = (LAS float*)(lds + MISC_OFF);
    for (int bh = blockIdx.x; bh < BATCH * NH; bh += G) {
        const int b = bh / NH, h = bh % NH;
        float v[8]; float run = 0.f;
#pragma unroll
        for (int i = 0; i < 8; ++i) { run += flog[((size_t)b * SEQ + 8 * tid + i) * 16 + h]; v[i] = run; }
        float incl = run;
#pragma unroll
        for (int o = 1; o < 64; o <<= 1) { const float nb = __shfl_up(incl, o); if (lane >= o) incl += nb; }
        if (lane == 63) wsum[wave] = incl;
        __syncthreads();
        float woff = 0.f;
#pragma unroll
        for (int w = 0; w < NWAVES; ++w) woff += (w < wave) ? wsum[w] : 0.f;
        const float excl = incl - run + woff;
        f32x4 o0 = (f32x4){v[0] + excl, v[1] + excl, v[2] + excl, v[3] + excl}, o1 = (f32x4){v[4] + excl, v[5] + excl, v[6] + excl, v[7] + excl};
        f32x4* dst = (f32x4*)(c2 + (size_t)bh * SEQ + 8 * tid); dst[0] = o0; dst[1] = o1;
        __syncthreads();
    }
}

__device__ __forceinline__ void fixup_phase(const float* edge, const float* raw01, const float* wconv, const float* bconv, bf16* act, int bx, int G) {
    int tid = threadIdx.x; asm volatile("" : "+v"(tid));
    const int gtid = bx * NTHR + tid, NGT = G * NTHR;
    for (int idx = gtid; idx < (M / 256) * 2 * FF; idx += NGT) {
        const int c = idx % FF, rr = (idx / FF) & 1, pm = idx / (2 * FF);
        const bool has = (pm % (SEQ / 256)) != 0;
        float r[2];
#pragma unroll
        for (int s = 0; s < 2; ++s) { const int col = s * FF + c;
            const float h0 = raw01[((size_t)pm * 2 + rr) * FF2 + col];
            const float e1 = has ? edge[((size_t)(pm - 1) * 2 + 1) * FF2 + col] : 0.f, e0 = has ? edge[((size_t)(pm - 1) * 2 + 0) * FF2 + col] : 0.f;
            const float hm1 = rr == 0 ? e1 : raw01[((size_t)pm * 2 + 0) * FF2 + col], hm2 = rr == 0 ? e0 : e1;
            r[s] = bconv[col] + wconv[2 * FF2 + col] * h0 + wconv[FF2 + col] * hm1 + wconv[col] * hm2; }
        const float sg = r[1] * __builtin_amdgcn_rcpf(1.f + ex2(-r[1] * LOG2E));
        act[(size_t)(pm * 256 + rr) * FF + c] = (bf16)(cvtpk(sg * r[0], 0.f) & 0xffffu);
    }
}


#ifndef DBG_STAGE
#define DBG_STAGE 0
#endif
#ifndef DBG_SKIP
#define DBG_SKIP 0
#endif
#ifndef DBG_FRAC
#define DBG_FRAC 1
#endif
__device__ __forceinline__ void dbg_dump_bf16(const bf16* src, float* out, int bx, int G) {
    int tid = threadIdx.x; asm volatile("" : "+v"(tid));
    for (size_t i = (size_t)bx * NTHR + tid; i < (size_t)M * D; i += (size_t)G * NTHR) { float v = __uint_as_float((unsigned)src[i] << 16); if (!(fabsf(v) < 1e30f)) v = 10000.f; out[i] = v; }
}

__device__ __forceinline__ float bf2f(bf16 v) { return __uint_as_float((unsigned)v << 16); }
__device__ __forceinline__ unsigned hash32(unsigned x) { x ^= x >> 16; x *= 0x7feb352du; x ^= x >> 15; x *= 0x846ca68bu; x ^= x >> 16; return x; }
__device__ __forceinline__ void dbg_acc(float* word, float got, float exp_) { const float d = fabsf(got - exp_) / (fabsf(exp_) + 0.05f); atomicMax((unsigned*)word, __float_as_uint(d)); }
__device__ __forceinline__ void dbg_check_qkv(const bf16* xn, const float* W  , const bf16* q, const bf16* k, const bf16* vt, float* word, int bx, int G) {
    int tid = threadIdx.x; asm volatile("" : "+v"(tid));
    const unsigned sidx = bx * NTHR + tid; if (sidx >= 16384u) return;
    const unsigned hsh = hash32(sidx * 2654435761u + 12345u); const int row = hsh % M, col = (hsh >> 15) % 3072;
    float acc = 0.f; for (int kk = 0; kk < D; ++kk) acc += bf2f(xn[(size_t)row * D + kk]) * W[(size_t)kk * 3088 + col];
    float got; if (col < 1024) { got = bf2f(q[(size_t)row * D + col]); acc *= QSCALE; } else if (col < 2048) got = bf2f(k[(size_t)row * D + col - 1024]); else got = bf2f(vt[(size_t)(col - 2048) * M + row]);
    dbg_acc(word, got, acc);
}
__device__ __forceinline__ void dbg_check_act(const bf16* xn, const float* Wup  , const float* wconv, const float* bconv, const bf16* act, float* word, int bx, int G, int mode) {
    int tid = threadIdx.x; asm volatile("" : "+v"(tid));
    const unsigned sidx = bx * NTHR + tid; if (sidx >= 16384u) return;
    const unsigned hsh = hash32(sidx * 2654435761u + 777u); int row = hsh % M; int c = (hsh >> 15) % FF;
    if (mode == 7) { row = (row & ~15) + 2 + (int)((hsh >> 27) % 12u); c = (c & ~127) + (int)((hsh >> 20) % 32u); }
    if (mode == 9) { row = (row & ~255 & ~(8 * 256)) + 2 + (int)((hsh >> 27) % 12u) + 16 * (int)((hsh >> 23) % 16u); c = c % 512; }
    if (mode == 8) { row = (row & ~255) + 2 + (int)((hsh >> 27) % 12u); }
    if (mode == 1) row = (row & ~255) + (sidx & 1);
    if (mode == 2) row = (row & ~63) + (sidx & 1);
    if (mode == 3) row = (row & ~15) + (sidx & 1);
    if (mode == 4) row = (row & ~15) + 2 + (int)((hsh >> 27) % 14u);
    if (mode == 5) row = (row & ~15) + 14 + (sidx & 1);
    if (mode == 6) row = (row & ~15) + 2 + (int)((hsh >> 27) % 12u);
    float hc[2];
    for (int s2 = 0; s2 < 2; ++s2) { const int col = s2 * FF + c; float tot = bconv[col];
        for (int tap = 0; tap < 3; ++tap) { const int r = row - 2 + tap; if ((r >> 12) != (row >> 12) || r < 0) continue;
            float acc = 0.f; for (int kk = 0; kk < D; ++kk) acc += bf2f(xn[(size_t)r * D + kk]) * Wup[(size_t)kk * FF2 + col];
            tot += wconv[tap * FF2 + col] * acc; }
        hc[s2] = tot; }
    const float exp_ = hc[0] * hc[1] / (1.f + __expf(-hc[1]));
    const float got_ = bf2f(act[(size_t)row * FF + c]);
    if (DBG_FRAC) { if (fabsf(got_ - exp_) > 0.1f * (fabsf(exp_) + 0.2f)) atomicAdd(word, 1.f / 16384.f); }
    else dbg_acc(word, got_, exp_);
}
__device__ __forceinline__ void dbg_check_attn(const bf16* q, const bf16* k, const bf16* vt, const float* c2, const bf16* o, float* word, int bx, int G, int mode) {
    int tid = threadIdx.x; asm volatile("" : "+v"(tid));
    const int lane = tid & 63; const unsigned sidx = bx * NWAVES + (tid >> 6); if (sidx >= 1024u) return;
    const unsigned hsh = hash32(sidx * 2654435761u + 99u); const int b = hsh % BATCH, h = (hsh >> 8) % NH; int qp = (hsh >> 14) % SEQ; if ((sidx & 7) == 0) qp = (qp & ~255) + (sidx >> 3) % 70;
    const size_t rb = (size_t)b * SEQ; const float qv = bf2f(q[(rb + qp) * D + h * 64 + lane]);
    float od = 0.f;
    if (mode == 0) {
        float mx = -INFINITY; for (int j = 0; j <= qp; ++j) { const float z = wave_sum(qv * bf2f(k[(rb + j) * D + h * 64 + lane])) - c2[((size_t)(b * NH + h)) * SEQ + j]; mx = fmaxf(mx, z); }
        float l = 0.f; for (int j = 0; j <= qp; ++j) { const float z = wave_sum(qv * bf2f(k[(rb + j) * D + h * 64 + lane])) - c2[((size_t)(b * NH + h)) * SEQ + j]; const float p = exp2f(z - mx); l += p; od += p * bf2f(vt[(size_t)(h * 64 + lane) * M + rb + j]); }
        od /= l;
    } else {
        float tail = 0.f; for (int j = qp - 1; j >= 0 && tail > -200.f; --j) { const float z = wave_sum(qv * bf2f(k[(rb + j) * D + h * 64 + lane]));
            const float sp = log2f(1.f + exp2f(z)); const float a = exp2f(z - sp + tail); tail -= sp; od += a * bf2f(vt[(size_t)(h * 64 + lane) * M + rb + j]); }
    }
    const float got = bf2f(o[(rb + qp) * D + h * 64 + lane]);
    const float d = fabsf(got - od) / (fabsf(od) + 0.02f); atomicMax((unsigned*)word, __float_as_uint(d));
}
__device__ __forceinline__ void dbg_check_resid(const float* base, const bf16* a, int K, const float* W, const float* hs, float* word, int bx, int G) {
    int tid = threadIdx.x; asm volatile("" : "+v"(tid));
    const unsigned sidx = bx * NTHR + tid; if (sidx >= 16384u) return;
    const unsigned hsh = hash32(sidx * 2654435761u + 4242u); const int row = hsh % M, col = (hsh >> 15) % D;
    float acc = 0.f; for (int kk = 0; kk < K; ++kk) acc += bf2f(a[(size_t)row * K + kk]) * W[(size_t)kk * D + col];
    const float exp_ = base[(size_t)row * D + col] + acc; dbg_acc(word, hs[(size_t)row * D + col], exp_);
}
#define DBG_BEGIN() do { if (bx0 == 0 && threadIdx.x == 0) *(float*)(PIN(unsigned char, 14) + WS_FLOG - 256) = 0.f; } while (0)
#define DBG_WORD ((float*)(PIN(unsigned char, 14) + WS_FLOG - 256))
#define DBG_FINISH() do { { int tz = threadIdx.x; asm volatile("" : "+v"(tz)); float* od_ = PIN(float, 13); for (size_t i = (size_t)bx0 * NTHR + tz; i < (size_t)M * D; i += (size_t)G0 * NTHR) od_[i] = 0.f; } GSYNC(); \
    if (bx0 == 0 && threadIdx.x == 0) PIN(float, 13)[0] = 10.f + 1000.f * *DBG_WORD; return; } while (0)
#define GSYNC() do { asm volatile("s_waitcnt vmcnt(0) lgkmcnt(0)" ::: "memory"); __builtin_amdgcn_fence(__ATOMIC_RELEASE, "agent"); grid.sync(); __builtin_amdgcn_fence(__ATOMIC_ACQUIRE, "agent"); } while (0)
__global__ void __launch_bounds__(NTHR, 2) fwd_kernel(Args a) {
    extern __shared__ __attribute__((aligned(16))) unsigned char lds_raw[];
    LAS unsigned char* lds = (LAS unsigned char*)lds_raw;
    cg::grid_group grid = cg::this_grid();
    const int tid = threadIdx.x, lane = tid & 63; const int wave = __builtin_amdgcn_readfirstlane(tid >> 6);
    const int G0 = gridDim.x, bx0 = blockIdx.x;
    const int vcu0 = (G0 % 8 == 0) ? (bx0 % 8) * (G0 / 8) + bx0 / 8 : bx0;
    if (tid == 0) {
#pragma unroll
        for (int i = 0; i < 13; ++i) *(LAS unsigned long long*)(lds + PTAB_OFF + 8 * i) = (unsigned long long)a.in[i];
        *(LAS unsigned long long*)(lds + PTAB_OFF + 8 * 13) = (unsigned long long)a.out; *(LAS unsigned long long*)(lds + PTAB_OFF + 8 * 14) = (unsigned long long)a.ws;
    }
    __syncthreads();
#define WSP(T, off) ((T*)(PIN(unsigned char, 14) + (off)))
#define XN WSP(bf16, WS_XN)
#define QO WSP(bf16, WS_QO)
#define KB WSP(bf16, WS_K)
#define VT WSP(bf16, WS_VT)
#define ACT WSP(bf16, WS_ACT)
#define FLOG WSP(float, WS_FLOG)
#define C2 WSP(float, WS_C2)
#define EDGE WSP(float, WS_EDGE)
#define RAW01 WSP(float, WS_RAW01)
#define HS PIN(float, 13)
#define XIN PIN(const float, 0)
    if (DBG_STAGE >= 30) DBG_BEGIN();
    prologue(lds, vcu0 * NWAVES + wave, G0 * NWAVES, wave, lane);
    __syncthreads();
    norm_phase<true>(XIN, PIN(const float, 1), XN, PIN(const float, 4), PIN(const float, 5), FLOG, lds, vcu0, G0);
    GSYNC();
    if (DBG_STAGE == 1) { dbg_dump_bf16(XN, HS, bx0, G0); return; }
    for (int l = 0; l < DEPTH; ++l) {
        const bool fox = !(l & 1); const int j = l >> 1;
        int G = G0, bx = bx0, vcu = vcu0; asm volatile("" : "+s"(G), "+s"(bx), "+s"(vcu));
        #define WL ((const bf16*)(PIN(unsigned char, 14) + WS_W + (size_t)l * W_LAYER))
        if (l > 0) {
            if (fox) norm_phase<true>(HS, PIN(const float, 1) + l * D, XN, PIN(const float, 4) + (size_t)j * D * 3088, PIN(const float, 5) + j * NH, FLOG, lds, vcu, G);
            else norm_phase<false>(HS, PIN(const float, 1) + l * D, XN, nullptr, nullptr, nullptr, lds, vcu, G);
            GSYNC();
        }
        if (fox) scan_phase(FLOG, C2, lds, G);
        { pg8::Gemm g{XN, WL + WO_QK / 2, M, 2048, D}; pg8::StaticOrder S; S.init(M, 2048, G, bx);
          pg8::EpiBf16<0> E{QO, D, nullptr, D, (size_t)(WS_K - WS_QO) / 2, QSCALE};
#ifndef NO_QK
          pg8::gemm_phase<pg8::EpiBf16<0>, pg8::StaticOrder, true, true>(lds, g, S, E);
#endif
        }
        { pg8::Gemm g{WL + WO_V / 2, XN, D, M, D}; pg8::StaticOrder S; S.init(D, M, G, bx);
          pg8::EpiBf16<0> E{VT, M, nullptr, 0, 0, 1.f};
#ifndef NO_VT
          pg8::gemm_phase<pg8::EpiBf16<0>, pg8::StaticOrder, true, true>(lds, g, S, E);
#endif
        }
        GSYNC();
        if (DBG_STAGE == 31 && l == 0) { dbg_check_qkv(XN, PIN(const float, 4), QO, KB, VT, DBG_WORD, bx, G); DBG_FINISH(); }
        if (DBG_STAGE == 32 && l == 0) { attn_phase<0>(vcu, G, QO, KB, VT, C2, XN, lds); GSYNC(); dbg_check_attn(QO, KB, VT, C2, XN, DBG_WORD, bx, G, 0); DBG_FINISH(); }
        if (DBG_STAGE == 35 && l == 1) { attn_phase<1>(vcu, G, QO, KB, VT, C2, XN, lds); GSYNC(); dbg_check_attn(QO, KB, VT, C2, XN, DBG_WORD, bx, G, 1); DBG_FINISH(); }
        if (DBG_STAGE == 2) { dbg_dump_bf16(QO, HS, bx, G); return; }
        if (DBG_STAGE == 3) { dbg_dump_bf16(KB, HS, bx, G); return; }
        if (DBG_STAGE == 4) { dbg_dump_bf16(VT, HS, bx, G); return; }
#ifndef NO_ATT0
        if (fox || DBG_STAGE == 10) attn_phase<0>(vcu, G, QO, KB, VT, C2, QO, lds);
#endif
#ifndef NO_ATT1
        if (!fox && DBG_STAGE != 10) attn_phase<1>(vcu, G, QO, KB, VT, C2, QO, lds);
#endif
        GSYNC();
        if (DBG_STAGE == 5) { dbg_dump_bf16(QO, HS, bx, G); return; }
        if (DBG_STAGE == 9 && l == 1) { dbg_dump_bf16(QO, HS, bx, G); return; }
        if ((DBG_SKIP & (fox ? 1 : 2)) != 0) {
            if (l == 0) { int tq = threadIdx.x; asm volatile("" : "+v"(tq)); const float* xs = XIN; float* hd = HS;
                for (size_t i = (size_t)bx * NTHR + tq; i < (size_t)M * D / 4; i += (size_t)G * NTHR) ((f32x4*)hd)[i] = ((const f32x4*)xs)[i]; }
        } else
        { pg8::Gemm g{QO, WL + WO_O / 2, M, D, D}; pg8::StaticOrder S; S.init(M, D, G, bx);
          EpiResid E{l == 0 ? XIN : HS, HS};
#ifndef NO_O
          pg8::gemm_phase<EpiResid, pg8::StaticOrder, true, true>(lds, g, S, E);
#endif
        }
        GSYNC();
        if (DBG_STAGE == 33 && l == 0) { dbg_check_resid(XIN, QO, D, PIN(const float, 6), HS, DBG_WORD, bx, G); DBG_FINISH(); }
        if (DBG_STAGE == 6) return;
        if ((DBG_SKIP & 4) != 0) continue;
        if ((DBG_STAGE == 8 || DBG_STAGE == 10) && l == 1) return;
        norm_phase<false>(HS, PIN(const float, 2) + l * D, XN, nullptr, nullptr, nullptr, lds, vcu, G);
        GSYNC();
        #define WCONV (PIN(const float, 10) + (size_t)l * 3 * FF2)
#define BCONV (PIN(const float, 11) + (size_t)l * FF2)
        { pg8::Gemm g{XN, WL + WO_UP / 2, M, FF2, D}; pg8::StaticOrder S; S.init(M, FF2, G, bx);
          EpiConvGate E{ACT, WCONV, BCONV, EDGE, RAW01, (LAS float*)(lds + XCH_OFF)};
#ifndef NO_UP
          pg8::gemm_phase<EpiConvGate, pg8::StaticOrder, true, true>(lds, g, S, E);
#endif
        }
        GSYNC();
        fixup_phase(EDGE, RAW01, WCONV, BCONV, ACT, bx, G);
        GSYNC();
        if (DBG_STAGE >= 40 && DBG_STAGE <= 49 && l == 0) { dbg_check_act(XN, PIN(const float, 9), WCONV, BCONV, ACT, DBG_WORD, bx, G, DBG_STAGE - 40); DBG_FINISH(); }
        { pg8::Gemm g{ACT, WL + WO_DN / 2, M, D, FF}; pg8::StaticOrder S; S.init(M, D, G, bx);
          EpiResid E{HS, HS};
#ifndef NO_DN
          pg8::gemm_phase<EpiResid, pg8::StaticOrder, true, true>(lds, g, S, E);
#endif
        }
        GSYNC();        if (DBG_STAGE == 7) return;
    }
    {
        int tidf = threadIdx.x; asm volatile("" : "+v"(tidf));
        const int lane = tidf & 63, gw = vcu0 * NWAVES + (tidf >> 6), NGW = G0 * NWAVES;
        f32x4 g[4];
#pragma unroll
        for (int jq = 0; jq < 4; ++jq) g[jq] = ((const f32x4*)PIN(const float, 3))[lane + 64 * jq];
        float* hs_ = HS;
        for (int m = gw; m < M; m += NGW) {
            f32x4* xr = (f32x4*)(hs_ + (size_t)m * D) + lane;
            f32x4 v[4]; float s = 0.f;
#pragma unroll
            for (int jq = 0; jq < 4; ++jq) { v[jq] = xr[64 * jq]; s += (v[jq].x * v[jq].x + v[jq].y * v[jq].y) + (v[jq].z * v[jq].z + v[jq].w * v[jq].w); }
            const float rstd = 1.0f / sqrtf(wave_sum(s) * (1.f / D) + NORM_EPS);
#pragma unroll
            for (int jq = 0; jq < 4; ++jq) xr[64 * jq] = v[jq] * rstd * g[jq];
        }
    }
}

extern "C" void kernel_launch(void* const* d_in, const int* in_sizes, int n_in, void* d_out, int out_size, void* d_ws, size_t ws_size, hipStream_t stream) {
    static int grid = 0;
    if (grid == 0) {
        if (n_in != 13 || out_size != M * D || ws_size < WS_END) { fprintf(stderr, "kernel_launch: unexpected problem shape (n_in %d, out %d, ws %zu)\n", n_in, out_size, ws_size); grid = -1; return; }
        int dev = 0, cus = 0, per_cu = 0;
        (void)hipGetDevice(&dev); (void)hipDeviceGetAttribute(&cus, hipDeviceAttributeMultiprocessorCount, dev);
        if (hipFuncSetAttribute((const void*)fwd_kernel, hipFuncAttributeMaxDynamicSharedMemorySize, LDS_BYTES) != hipSuccess) { fprintf(stderr, "kernel_launch: hipFuncSetAttribute failed\n"); }
        if (hipOccupancyMaxActiveBlocksPerMultiprocessor(&per_cu, (const void*)fwd_kernel, NTHR, LDS_BYTES) != hipSuccess || per_cu < 1) { fprintf(stderr, "kernel_launch: occupancy query gave %d; using 1\n", per_cu); per_cu = 1; }
        (void)hipGetLastError();
        grid = cus * per_cu;
    }
    if (grid < 0) return;
    Args a{};
    for (int i = 0; i < 13; ++i) a.in[i] = (const float*)d_in[i];
    a.out = (float*)d_out; a.ws = (unsigned char*)d_ws;
    void* args[] = {&a};
    const hipError_t e = hipLaunchCooperativeKernel((const void*)fwd_kernel, dim3(grid), dim3(NTHR), args, LDS_BYTES, stream);
    if (e != hipSuccess) fprintf(stderr, "kernel_launch: cooperative launch failed: %s (grid %d)\n", hipGetErrorString(e), grid);
}
```

```cpp
#include <hip/hip_runtime.h>
#include <hip/hip_cooperative_groups.h>
#include <cstdio>
#include <cstdint>
namespace cg = cooperative_groups;
namespace pg8 {
#define PG8_LAS __attribute__((address_space(3)))
typedef unsigned short bf16_t;
typedef short bf16x8 __attribute__((ext_vector_type(8)));
typedef float f32x4 __attribute__((ext_vector_type(4)));
typedef unsigned u32x4 __attribute__((ext_vector_type(4)));
constexpr int BM = 256, BK = 64, HALF = 128, HTB = HALF * BK * 2  , STAGE_BYTES = 8 * HTB, NXCD = 8, WGM = 8;

__host__ __device__ __forceinline__ int lds_byte(int r, int c) { const int st = (r >> 4) * 2 + (c >> 5), rr = r & 15, cc = c & 31, ob = rr * 64 + cc * 2; return st * 1024 + (ob ^ (((ob >> 9) & 1) << 5)); }
__host__ __device__ __forceinline__ void stage_rc(int b, int& R, int& C) { const int st = b / 1024, sb = b % 1024, swz = sb ^ (((sb >> 9) & 1) << 5); R = (st >> 1) * 16 + swz / 64; C = (st & 1) * 32 + (swz % 64) / 2; }
__host__ __device__ __forceinline__ int perm32(int rho) { const int n = rho >> 4, i = rho & 15; return 8 * (i >> 2) + 4 * n + (i & 3); }

struct Unit { int pm, pn; };
struct Gemm { const bf16_t* A; const bf16_t* Bt; int M, N, K; };

struct StaticOrder {
    int nM, nN, nwg, G, c;
    __host__ __device__ void init(int M, int N, int G_, int c_) { nM = M / BM; nN = N / BM; nwg = nM * nN; G = G_; c = c_; }
    __host__ __device__ bool next(int i, Unit& u) const {
        const long L = (long)i * G + c; if (L >= nwg) return false;
        int wgid = (int)L; { const int q = nwg / NXCD, r = nwg % NXCD, xcd = wgid % NXCD, off = wgid / NXCD; wgid = (xcd < r ? xcd * (q + 1) : r * (q + 1) + (xcd - r) * q) + off; }
        const int nig = WGM * nN, gid = wgid / nig, fm = gid * WGM, gsz = (nM - fm) < WGM ? (nM - fm) : WGM;
        u.pm = fm + ((wgid % nig) % gsz); u.pn = (wgid % nig) / gsz; return true;
    }
    __device__ __forceinline__ void a_ready(const Unit&) const {}
    __device__ __forceinline__ void done(const Unit&) const {}
};

__device__ __forceinline__ unsigned cvt_pk_bf16(float lo, float hi) { unsigned r; asm volatile("v_cvt_pk_bf16_f32 %0, %1, %2" : "=v"(r) : "v"(lo), "v"(hi)); return r; }
typedef float f32x2 __attribute__((ext_vector_type(2)));
__device__ __forceinline__ f32x2 gelu_pk(f32x2 v) {
    const f32x2 av = __builtin_elementwise_abs(v), d = av * 0.2316418882f + 1.0f;
    f32x2 t; t.x = __builtin_amdgcn_rcpf(d.x); t.y = __builtin_amdgcn_rcpf(d.y);
    f32x2 q = t * 0.5307027145f + (-0.7265760135f); q = q * t + 0.7107068705f; q = q * t + (-0.142248368f); q = q * t + 0.127414796f; q = q * t;
    const f32x2 s = (v * v) * (-0.72134752044f);
    f32x2 e; e.x = __builtin_amdgcn_exp2f(s.x); e.y = __builtin_amdgcn_exp2f(s.y);
    const f32x2 m = v * (q * e), r = v - m;
    f32x2 o; o.x = v.x < 0.f ? m.x : r.x; o.y = v.y < 0.f ? m.y : r.y; return o;
}

template <int ACT  > struct EpiBf16 {
    static constexpr bool PERM = true, AFTER_DRAIN = false; static_assert(ACT == 0 || ACT == 1, "EpiBf16: ACT is 0 (none) or 1 (gelu_pk)");
    bf16_t* O; int ldc; const float* bias; int split_cols; size_t split_stride; float scale0;
    __device__ __forceinline__ void operator()(const f32x4 (&acc)[2][2][4][2], const Unit& u, int wr, int wc, int fr, int fq) const {
        const int row0 = u.pm * BM + wr * 64 + fr; int colt = u.pn * BM; bf16_t* base = O;
        float sc = 1.f; if (split_cols) { const int t = colt / split_cols; base += (size_t)t * split_stride; colt -= t * split_cols; if (t == 0) sc = scale0; }
        const int col0 = colt + wc * 32 + 8 * fq, bcol0 = u.pn * BM + wc * 32 + 8 * fq;
        f32x4 bv[2][2];
#pragma unroll
        for (int bj = 0; bj < 2; ++bj)
#pragma unroll
            for (int n = 0; n < 2; ++n) bv[bj][n] = bias ? *(const f32x4*)(bias + bcol0 + bj * HALF + 4 * n) : (f32x4){0.f, 0.f, 0.f, 0.f};
#pragma unroll
        for (int ai = 0; ai < 2; ++ai)
#pragma unroll
            for (int m = 0; m < 4; ++m) { bf16_t* rowp = base + (size_t)(row0 + ai * HALF + m * 16) * ldc + col0;
#pragma unroll
                for (int bj = 0; bj < 2; ++bj) { f32x4 v0 = acc[ai][bj][m][0] + bv[bj][0], v1 = acc[ai][bj][m][1] + bv[bj][1];
                    if (ACT == 1) { f32x2 a = gelu_pk((f32x2){v0[0], v0[1]}), b = gelu_pk((f32x2){v0[2], v0[3]}), c = gelu_pk((f32x2){v1[0], v1[1]}), d = gelu_pk((f32x2){v1[2], v1[3]});
                        v0 = (f32x4){a.x, a.y, b.x, b.y}; v1 = (f32x4){c.x, c.y, d.x, d.y}; }
                    v0 = v0 * sc; v1 = v1 * sc; u32x4 w; w.x = cvt_pk_bf16(v0[0], v0[1]); w.y = cvt_pk_bf16(v0[2], v0[3]); w.z = cvt_pk_bf16(v1[0], v1[1]); w.w = cvt_pk_bf16(v1[2], v1[3]);
                    *(u32x4*)(rowp + bj * HALF) = w; } }
    }
};
template <class Epi, class Sched, bool ALIGN_EPI = false, bool SP2 = false>
__device__ __forceinline__ void gemm_phase(PG8_LAS unsigned char* lds, const Gemm g, const Sched& S, const Epi& E) {
    int tid_ = threadIdx.x; asm volatile("" : "+v"(tid_));
    const int tid = tid_, wid = __builtin_amdgcn_readfirstlane(tid >> 6), lane = tid & 63, wr = wid >> 2, wc = wid & 3, fr = lane & 15, fq = lane >> 4;
    const int K = g.K, nt = K / BK;
    unsigned voffA[2], voffB[2];
#pragma unroll
    for (int i = 0; i < 2; ++i) { int R, C; stage_rc(tid * 16 + i * 8192, R, C); const int Rb = Epi::PERM ? ((R & ~31) + perm32(R & 31)) : R;
        voffA[i] = (unsigned)(R * K + C) * 2u; voffB[i] = (unsigned)(Rb * K + C) * 2u; }
    const size_t kstep = (size_t)(BK * 2);
    const size_t hstep = (size_t)HALF * K * 2;
    const size_t tstep = 2 * hstep;
    const unsigned ldsw = (unsigned)wid * 1024u;
    const int aoff = lds_byte(wr * 64 + fr, fq * 8), boff = lds_byte(wc * 32 + fr, fq * 8);
#define PG8_SA(b, h) (((b) * 2 + (h)) * HTB)
#define PG8_SB(b, h) ((4 + (b) * 2 + (h)) * HTB)
#define PG8_STAGE(bufoff, gbase, voff) do { _Pragma("unroll") for (int _i = 0; _i < 2; ++_i) \
        __builtin_amdgcn_global_load_lds((const unsigned*)((const char*)(gbase) + (voff)[_i]), (PG8_LAS unsigned*)(lds + (bufoff) + ldsw + _i * 8192), 16, 0, 0); } while (0)
#define PG8_LDA(dst, b, h) do { _Pragma("unroll") for (int m = 0; m < 4; ++m) _Pragma("unroll") for (int k = 0; k < 2; ++k) dst[m][k] = *(const PG8_LAS bf16x8*)(lds + PG8_SA(b, h) + aoff + m * 2048 + k * 1024); } while (0)
#define PG8_LDB(dst, b, h) do { _Pragma("unroll") for (int n = 0; n < 2; ++n) _Pragma("unroll") for (int k = 0; k < 2; ++k) dst[n][k] = *(const PG8_LAS bf16x8*)(lds + PG8_SB(b, h) + boff + n * 2048 + k * 1024); } while (0)
#define PG8_MMA(ai, bj, At, Bt) do { __builtin_amdgcn_s_setprio(1); _Pragma("unroll") for (int m = 0; m < 4; ++m) _Pragma("unroll") for (int n = 0; n < 2; ++n) _Pragma("unroll") for (int k = 0; k < 2; ++k) \
        acc[ai][bj][m][n] = __builtin_amdgcn_mfma_f32_16x16x32_bf16(Bt[n][k], At[m][k], acc[ai][bj][m][n], 0, 0, 0); __builtin_amdgcn_s_setprio(0); } while (0)
#define PG8_WAIT_V(n) asm volatile("s_waitcnt vmcnt(" #n ")" ::: "memory")
#define PG8_WAIT_L(n) asm volatile("s_waitcnt lgkmcnt(" #n ")" ::: "memory")
#define PG8_BAR __builtin_amdgcn_s_barrier()
#define PG8_SCHED __builtin_amdgcn_sched_barrier(0)
    Unit cur, nxt; int ui = 0;
    if (!S.next(0, cur)) return;
    f32x4 acc[2][2][4][2];
#pragma unroll
    for (int a = 0; a < 2; ++a)
#pragma unroll
        for (int b = 0; b < 2; ++b)
#pragma unroll
            for (int m = 0; m < 4; ++m)
#pragma unroll
                for (int n = 0; n < 2; ++n) acc[a][b][m][n] = (f32x4){0.f, 0.f, 0.f, 0.f};
    bf16x8 At[4][2], B0[2][2], B1[2][2];
    const char* cA = (const char*)g.A + (size_t)cur.pm * tstep; const char* cB = (const char*)g.Bt + (size_t)cur.pn * tstep;
    S.a_ready(cur);
    if constexpr (SP2) {
        PG8_STAGE(PG8_SB(0, 0), cB, voffB); PG8_STAGE(PG8_SB(0, 1), cB + hstep, voffB); PG8_STAGE(PG8_SA(0, 0), cA, voffA); PG8_STAGE(PG8_SA(0, 1), cA + hstep, voffA);
        if (wr == 1) PG8_BAR;
        PG8_WAIT_V(2); PG8_BAR;
        PG8_STAGE(PG8_SB(1, 0), cB + kstep, voffB); PG8_STAGE(PG8_SA(1, 0), cA + kstep, voffA); PG8_STAGE(PG8_SB(1, 1), cB + hstep + kstep, voffB);
        PG8_WAIT_V(6); PG8_BAR;
    } else {
        PG8_STAGE(PG8_SB(0, 0), cB, voffB); PG8_STAGE(PG8_SA(0, 0), cA, voffA); PG8_STAGE(PG8_SB(0, 1), cB + hstep, voffB); PG8_STAGE(PG8_SA(0, 1), cA + hstep, voffA);
        if (wr == 1) PG8_BAR;
        PG8_WAIT_V(4); PG8_BAR;
        PG8_STAGE(PG8_SB(1, 0), cB + kstep, voffB); PG8_STAGE(PG8_SA(1, 0), cA + kstep, voffA); PG8_STAGE(PG8_SB(1, 1), cB + hstep + kstep, voffB);
        PG8_WAIT_V(6); PG8_BAR;
    }
    for (;;) {
        const bool has_next = S.next(ui + 1, nxt);
        const char* nA = has_next ? (const char*)g.A + (size_t)nxt.pm * tstep : cA; const char* nB = has_next ? (const char*)g.Bt + (size_t)nxt.pn * tstep : cB;
        for (int t = 0; t < nt; t += 2) {
            const bool last = (t == nt - 2);
            const char* a1 = cA + (size_t)(t + 1) * kstep;
            const char* a2 = last ? nA : cA + (size_t)(t + 2) * kstep; const char* b2 = last ? nB : cB + (size_t)(t + 2) * kstep;
            const char* a3 = a2 + kstep; const char* b3 = b2 + kstep;
            if (last && has_next) S.a_ready(nxt);
            if constexpr (SP2) {
            PG8_LDB(B0, 0, 0); PG8_LDB(B1, 0, 1); PG8_SCHED; PG8_LDA(At, 0, 0); PG8_STAGE(PG8_SA(1, 1), a1 + hstep, voffA);
            PG8_WAIT_V(8); PG8_WAIT_L(0); PG8_BAR; PG8_MMA(0, 0, At, B0); PG8_MMA(0, 1, At, B1); PG8_BAR; PG8_SCHED;
            PG8_LDA(At, 0, 1); PG8_STAGE(PG8_SB(0, 0), b2, voffB); PG8_STAGE(PG8_SB(0, 1), b2 + hstep, voffB); PG8_STAGE(PG8_SA(0, 0), a2, voffA);
            PG8_WAIT_V(8); PG8_WAIT_L(0); PG8_BAR; PG8_MMA(1, 0, At, B0); PG8_MMA(1, 1, At, B1); PG8_BAR; PG8_SCHED;
            PG8_LDB(B0, 1, 0); PG8_LDB(B1, 1, 1); PG8_SCHED; PG8_LDA(At, 1, 0); PG8_STAGE(PG8_SA(0, 1), a2 + hstep, voffA);
            PG8_WAIT_V(8); PG8_WAIT_L(0); PG8_BAR; PG8_MMA(0, 0, At, B0); PG8_MMA(0, 1, At, B1); PG8_BAR; PG8_SCHED;
            PG8_LDA(At, 1, 1); PG8_STAGE(PG8_SB(1, 0), b3, voffB); PG8_STAGE(PG8_SB(1, 1), b3 + hstep, voffB); PG8_STAGE(PG8_SA(1, 0), a3, voffA);
            PG8_WAIT_V(8); PG8_WAIT_L(0); PG8_BAR; PG8_MMA(1, 0, At, B0); PG8_MMA(1, 1, At, B1); PG8_BAR; PG8_SCHED;
            } else {
            PG8_LDB(B0, 0, 0); PG8_SCHED; PG8_LDA(At, 0, 0); PG8_STAGE(PG8_SA(1, 1), a1 + hstep, voffA);
            PG8_WAIT_L(8); PG8_BAR; PG8_WAIT_L(0); PG8_MMA(0, 0, At, B0); PG8_BAR; PG8_SCHED;
            PG8_LDB(B1, 0, 1); PG8_STAGE(PG8_SB(0, 0), b2, voffB);
            PG8_BAR; PG8_WAIT_L(0); PG8_MMA(0, 1, At, B1); PG8_BAR;
            PG8_LDA(At, 0, 1); PG8_STAGE(PG8_SA(0, 0), a2, voffA);
            PG8_BAR; PG8_WAIT_L(0); PG8_MMA(1, 0, At, B0); PG8_BAR; PG8_SCHED;
            PG8_STAGE(PG8_SB(0, 1), b2 + hstep, voffB);
            PG8_WAIT_V(6); PG8_BAR; PG8_MMA(1, 1, At, B1); PG8_BAR;
            PG8_LDB(B0, 1, 0); PG8_SCHED; PG8_LDA(At, 1, 0); PG8_STAGE(PG8_SA(0, 1), a2 + hstep, voffA);
            PG8_WAIT_L(8); PG8_BAR; PG8_WAIT_L(0); PG8_MMA(0, 0, At, B0); PG8_BAR; PG8_SCHED;
            PG8_LDB(B1, 1, 1); PG8_STAGE(PG8_SB(1, 0), b3, voffB);
            PG8_BAR; PG8_WAIT_L(0); PG8_MMA(0, 1, At, B1); PG8_BAR;
            PG8_LDA(At, 1, 1); PG8_STAGE(PG8_SA(1, 0), a3, voffA);
            PG8_BAR; PG8_WAIT_L(0); PG8_MMA(1, 0, At, B0); PG8_BAR; PG8_SCHED;
            PG8_STAGE(PG8_SB(1, 1), b3 + hstep, voffB);
            PG8_WAIT_V(6); PG8_BAR; PG8_MMA(1, 1, At, B1); PG8_BAR;
            }
        }
        if constexpr (ALIGN_EPI) { if (wr == 0) PG8_BAR; }
        if constexpr (!Epi::AFTER_DRAIN) { E(acc, cur, wr, wc, fr, fq); S.done(cur); }
        if (!has_next) break;
#pragma unroll
        for (int a = 0; a < 2; ++a)
#pragma unroll
            for (int b = 0; b < 2; ++b)
#pragma unroll
                for (int m = 0; m < 4; ++m)
#pragma unroll
                    for (int n = 0; n < 2; ++n) acc[a][b][m][n] = (f32x4){0.f, 0.f, 0.f, 0.f};
        cur = nxt; cA = nA; cB = nB; ++ui;
        if constexpr (ALIGN_EPI) { if (wr == 1) PG8_BAR; }
    }
    PG8_WAIT_V(0);
    if constexpr (!ALIGN_EPI) { if (wr == 0) PG8_BAR; }
    PG8_BAR;
    if constexpr (Epi::AFTER_DRAIN) { E.fused(acc, cur, wr, wc, fr, fq, lds, wid, lane); S.done(cur); }
#undef PG8_SA
#undef PG8_SB
#undef PG8_STAGE
#undef PG8_LDA
#undef PG8_LDB
#undef PG8_MMA
#undef PG8_WAIT_V
#undef PG8_WAIT_L
#undef PG8_BAR
#undef PG8_SCHED
}
}
#ifndef DBG_STAGE
#define DBG_STAGE 0
#endif
#ifndef DBG_SKIP
#define DBG_SKIP 0
#endif
constexpr int BATCH = 8, SEQ = 4096, D = 1024, NH = 16, HD = 64, FF = 2816, FF2 = 2 * FF, DEPTH = 4;
constexpr int M = BATCH * SEQ;
constexpr float NORM_EPS = 1e-6f;
constexpr float LOG2E = 1.4426950408889634f;
constexpr float QSCALE = 0.125f * LOG2E;
constexpr int NWAVES = 8, NTHR = 512;

#define LAS __attribute__((address_space(3)))
typedef unsigned short bf16;
typedef float f32x4 __attribute__((ext_vector_type(4)));
typedef float f32x16 __attribute__((ext_vector_type(16)));
typedef short bf16x8 __attribute__((ext_vector_type(8)));
typedef unsigned u32x4 __attribute__((ext_vector_type(4)));
typedef unsigned u32x2 __attribute__((ext_vector_type(2)));

constexpr size_t MiB = 1u << 20;
constexpr size_t W_LAYER = 25 * MiB;
constexpr size_t WO_QK = 0, WO_V = 4 * MiB, WO_O = 6 * MiB, WO_UP = 8 * MiB, WO_DN = 19 * MiB;
constexpr size_t WS_W = 0;
constexpr size_t WS_FLOG = 100 * MiB;
constexpr size_t WS_C2 = 102 * MiB;
constexpr size_t WS_EDGE = 104 * MiB;
constexpr size_t WS_RAW01 = 110 * MiB;
constexpr size_t WS_XN = 116 * MiB;
constexpr size_t WS_QO = 180 * MiB;
constexpr size_t WS_K = 244 * MiB;
constexpr size_t WS_VT = 308 * MiB;
constexpr size_t WS_ACT = 180 * MiB;
constexpr size_t WS_END = 372 * MiB;
static_assert(WS_ACT + (size_t)M * FF * 2 <= WS_END, "ws map");

constexpr int RING_BYTES = 131072, XCH_OFF = RING_BYTES, MISC_OFF = XCH_OFF + 8192, PTAB_OFF = MISC_OFF + 256, LDS_BYTES = 147456;

typedef float f32x2_t __attribute__((ext_vector_type(2))); typedef __bf16 bf16x2_t __attribute__((ext_vector_type(2)));
__device__ __forceinline__ unsigned cvtpk(float lo, float hi) { f32x2_t v = {lo, hi}; bf16x2_t b = __builtin_convertvector(v, bf16x2_t); return __builtin_bit_cast(unsigned, b); }
__device__ __forceinline__ float wave_sum(float v) {
#pragma unroll
    for (int o = 1; o < 64; o <<= 1) v += __shfl_xor(v, o);
    return v;
}
__device__ __forceinline__ float ex2(float x) { return __builtin_amdgcn_exp2f(x); }
__device__ __forceinline__ float lg2(float x) { return __builtin_amdgcn_logf(x); }
struct EpiResid {
    static constexpr bool PERM = true, AFTER_DRAIN = false;
    const float* base; float* out;
    __device__ __forceinline__ void operator()(const pg8::f32x4 (&acc)[2][2][4][2], const pg8::Unit& u, int wr, int wc, int fr, int fq) const {
        const int row0 = u.pm * 256 + wr * 64 + fr, col0 = u.pn * 256 + wc * 32 + 8 * fq;
#pragma unroll
        for (int ai = 0; ai < 2; ++ai)
#pragma unroll
            for (int m = 0; m < 4; ++m) { const size_t off = (size_t)(row0 + ai * 128 + m * 16) * D + col0;
#pragma unroll
                for (int bj = 0; bj < 2; ++bj) { const f32x4 b0 = *(const f32x4*)(base + off + bj * 128), b1 = *(const f32x4*)(base + off + bj * 128 + 4);
                    *(f32x4*)(out + off + bj * 128) = b0 + acc[ai][bj][m][0]; *(f32x4*)(out + off + bj * 128 + 4) = b1 + acc[ai][bj][m][1]; }
                asm volatile("" ::: "memory"); }
    }
};

__device__ __forceinline__ float dpp_ror1(float v) { return __builtin_bit_cast(float, __builtin_amdgcn_update_dpp(0, __builtin_bit_cast(int, v), 0x121, 0xf, 0xf, false)); }
__device__ __forceinline__ float dpp_ror2(float v) { return __builtin_bit_cast(float, __builtin_amdgcn_update_dpp(0, __builtin_bit_cast(int, v), 0x122, 0xf, 0xf, false)); }

struct EpiConvGate {
    static constexpr bool PERM = true, AFTER_DRAIN = false;
    bf16* act; const float* wconv; const float* bconv; float* edge; float* raw01; LAS float* xch;
    __device__ __forceinline__ void operator()(const pg8::f32x4 (&acc)[2][2][4][2], const pg8::Unit& u, int wr, int wc, int fr, int fq) const {
        const int lc0 = wc * 32 + 8 * fq, ch0 = u.pn * 128 + lc0;
        if (fr >= 14) {
#pragma unroll
            for (int ai = 0; ai < 2; ++ai) { const int q = 2 * ai + wr;
#pragma unroll
                for (int bj = 0; bj < 2; ++bj)
#pragma unroll
                    for (int n = 0; n < 2; ++n) *(LAS f32x4*)(xch + (q * 2 + (fr - 14)) * 256 + bj * 128 + lc0 + 4 * n) = acc[ai][bj][3][n]; }
            if (wr == 1) {
#pragma unroll
                for (int bj = 0; bj < 2; ++bj)
#pragma unroll
                    for (int n = 0; n < 2; ++n) *(f32x4*)(edge + ((size_t)u.pm * 2 + (fr - 14)) * FF2 + bj * FF + ch0 + 4 * n) = acc[1][bj][3][n]; }
        }
        if (wr == 0 && fr < 2) {
#pragma unroll
            for (int bj = 0; bj < 2; ++bj)
#pragma unroll
                for (int n = 0; n < 2; ++n) *(f32x4*)(raw01 + ((size_t)u.pm * 2 + fr) * FF2 + bj * FF + ch0 + 4 * n) = acc[0][bj][0][n];
        }
        asm volatile("s_waitcnt lgkmcnt(0)" ::: "memory"); __builtin_amdgcn_s_barrier(); asm volatile("" ::: "memory");
        const bool f1 = fr >= 1, f2 = fr >= 2;
#pragma unroll
        for (int n = 0; n < 2; ++n) {
            const f32x4 wu0 = *(const f32x4*)(wconv + ch0 + 4 * n), wu1 = *(const f32x4*)(wconv + FF2 + ch0 + 4 * n), wu2 = *(const f32x4*)(wconv + 2 * FF2 + ch0 + 4 * n), bu = *(const f32x4*)(bconv + ch0 + 4 * n);
            const f32x4 wg0 = *(const f32x4*)(wconv + FF + ch0 + 4 * n), wg1 = *(const f32x4*)(wconv + FF2 + FF + ch0 + 4 * n), wg2 = *(const f32x4*)(wconv + 2 * FF2 + FF + ch0 + 4 * n), bg = *(const f32x4*)(bconv + FF + ch0 + 4 * n);
#pragma unroll
            for (int ai = 0; ai < 2; ++ai) {
                const int q = 2 * ai + wr;
                f32x4 pru = (f32x4){0.f, 0.f, 0.f, 0.f}, prg = pru;
                if (q > 0 && fr >= 14) { pru = *(const LAS f32x4*)(xch + ((q - 1) * 2 + (fr - 14)) * 256 + lc0 + 4 * n); prg = *(const LAS f32x4*)(xch + ((q - 1) * 2 + (fr - 14)) * 256 + 128 + lc0 + 4 * n); }
#pragma unroll
                for (int m = 0; m < 4; ++m) {
                    float r4[4];
#pragma unroll
                    for (int j = 0; j < 4; ++j) {
                        const float vu = acc[ai][0][m][n][j], vg = acc[ai][1][m][n][j];
                        const float pu = m > 0 ? acc[ai][0][m > 0 ? m - 1 : 0][n][j] : pru[j];
                        const float pg = m > 0 ? acc[ai][1][m > 0 ? m - 1 : 0][n][j] : prg[j];
                        const float vu1 = dpp_ror1(vu), pu1 = dpp_ror1(pu), vu2 = dpp_ror2(vu), pu2 = dpp_ror2(pu);
                        const float vg1 = dpp_ror1(vg), pg1 = dpp_ror1(pg), vg2 = dpp_ror2(vg), pg2 = dpp_ror2(pg);
                        const float u1 = f1 ? vu1 : pu1, u2 = f2 ? vu2 : pu2;
                        const float g1 = f1 ? vg1 : pg1, g2 = f2 ? vg2 : pg2;
                        const float nb = (DBG_STAGE == 21) ? 0.f : 1.f;
                        const float hu = bu[j] + wu2[j] * vu + nb * (wu1[j] * u1 + wu0[j] * u2);
                        const float hg = bg[j] + wg2[j] * vg + nb * (wg1[j] * g1 + wg0[j] * g2);
                        const float sg = hg * __builtin_amdgcn_rcpf(1.f + ex2(-hg * LOG2E));
                        r4[j] = sg * hu;
                    }
                    const int row = u.pm * 256 + ai * 128 + wr * 64 + m * 16 + fr;
                    u32x2 w; w.x = cvtpk(r4[0], r4[1]); w.y = cvtpk(r4[2], r4[3]);
                    if (!(ai == 0 && m == 0 && wr == 0 && fr < 2)) *(u32x2*)(act + (size_t)row * FF + ch0 + 4 * n) = w;
                    asm volatile("" ::: "memory");
                }
            }
        }
    }
};
constexpr int A_ROWB = 144, A_KBUF = 64 * A_ROWB, A_OFF_K = 0, A_OFF_V = 2 * A_KBUF, A_OFF_C = 4 * A_KBUF, A_OFF_FLAG = A_OFF_C + 512;

__device__ __forceinline__ float lane_partner(float v, int hi) {
    auto rr = __builtin_amdgcn_permlane32_swap(__float_as_uint(v), __float_as_uint(v), false, false);
    return __uint_as_float(hi ? rr[0] : rr[1]);
}

template <int MODE>
__device__ __forceinline__ void attn_unit(int b, int h, int qb, const bf16* Q, const bf16* __restrict__ K, const bf16* __restrict__ VT, const float* __restrict__ C2, bf16* O, LAS unsigned char* lds) {
    int tid_ = threadIdx.x; asm volatile("" : "+v"(tid_));
    const int tid = tid_, lane = tid & 63, r32 = lane & 31, hi = lane >> 5; const int wid = __builtin_amdgcn_readfirstlane(tid >> 6);
    const size_t rowbase = (size_t)b * SEQ; const int q0 = qb * 256; const int NT = (q0 + 256) / 64;
    const int qabs = q0 + wid * 32 + r32;
    const bf16* Qw = Q + (rowbase + qabs) * D + h * 64;
    bf16x8 qr[4];
#pragma unroll
    for (int d0 = 0; d0 < 4; ++d0) qr[d0] = *(const bf16x8*)(Qw + d0 * 16 + hi * 8);
    const int lrow = tid >> 3, lch = tid & 7;
    const bf16* ksrc = K + (rowbase + lrow) * D + h * 64 + lch * 8;
    const bf16* vsrc = VT + (size_t)(h * 64 + lrow) * M + rowbase + lch * 8;
    const float* csrc = C2 + ((size_t)(b * NH + h)) * SEQ + 4 * (tid & 15);
    const int ldst = lrow * A_ROWB + lch * 16;
    const int krow = (r32 & ~12) | ((r32 & 4) << 1) | ((r32 & 8) >> 1);
    const int koff = krow * A_ROWB + hi * 16, voff = r32 * A_ROWB + hi * 16;
    u32x4 kreg, vreg; f32x4 creg = (f32x4){0.f, 0.f, 0.f, 0.f};
#define A_TILE(i) (MODE ? (NT - 1 - (i)) : (i))
#define A_LOAD(t) do { kreg = *(const u32x4*)(ksrc + (size_t)(t) * 64 * D); vreg = *(const u32x4*)(vsrc + (t) * 64); if (MODE == 0 && tid < 16) creg = *(const f32x4*)(csrc + (t) * 64); } while (0)
#define A_WRITE(buf) do { *(LAS u32x4*)(lds + A_OFF_K + (buf) * A_KBUF + ldst) = kreg; *(LAS u32x4*)(lds + A_OFF_V + (buf) * A_KBUF + ldst) = vreg; \
        if (MODE == 0 && tid < 16) *(LAS f32x4*)(lds + A_OFF_C + (buf) * 256 + tid * 16) = (DBG_STAGE == 20) ? creg * 0.f : -creg; } while (0)
    f32x16 o0, o1;
#pragma unroll
    for (int r = 0; r < 16; ++r) { o0[r] = 0.f; o1[r] = 0.f; }
    float mrun = -INFINITY, lrun = 0.f, carry = 0.f;
    A_LOAD(A_TILE(0)); A_WRITE(0);
    asm volatile("" : "+v"(qr[0]), "+v"(qr[1]), "+v"(qr[2]), "+v"(qr[3]));
    __syncthreads();
    for (int i = 0; i < NT; ++i) {
        const int buf = i & 1, t = A_TILE(i);
        if (i + 1 < NT) A_LOAD(A_TILE(i + 1));
        const LAS unsigned char* kb = lds + A_OFF_K + buf * A_KBUF; const LAS unsigned char* vb = lds + A_OFF_V + buf * A_KBUF;
        f32x16 s0, s1;
        if (MODE == 0) {
            const LAS float* cb = (const LAS float*)(lds + A_OFF_C + buf * 256);
#pragma unroll
            for (int g = 0; g < 2; ++g) {
                const f32x4 a0 = *(const LAS f32x4*)(cb + 16 * g + 8 * hi), a1 = *(const LAS f32x4*)(cb + 16 * g + 8 * hi + 4);
                const f32x4 b0 = *(const LAS f32x4*)(cb + 32 + 16 * g + 8 * hi), b1 = *(const LAS f32x4*)(cb + 32 + 16 * g + 8 * hi + 4);
#pragma unroll
                for (int e = 0; e < 4; ++e) { s0[8 * g + e] = a0[e]; s0[8 * g + 4 + e] = a1[e]; s1[8 * g + e] = b0[e]; s1[8 * g + 4 + e] = b1[e]; }
            }
        } else {
#pragma unroll
            for (int r = 0; r < 16; ++r) { s0[r] = 0.f; s1[r] = 0.f; }
        }
#pragma unroll
        for (int d0 = 0; d0 < 4; ++d0) {
            const bf16x8 k0 = *(const LAS bf16x8*)(kb + koff + d0 * 32), k1 = *(const LAS bf16x8*)(kb + 32 * A_ROWB + koff + d0 * 32);
            s0 = __builtin_amdgcn_mfma_f32_32x32x16_bf16(k0, qr[d0], s0, 0, 0, 0);
            s1 = __builtin_amdgcn_mfma_f32_32x32x16_bf16(k1, qr[d0], s1, 0, 0, 0);
        }
        const bool band = t >= NT - 4;
        const int kbase = t * 64 + 8 * hi;
        if (MODE == 0) {
            if (band) {
#pragma unroll
                for (int r = 0; r < 16; ++r) { const int key = kbase + (r & 7) + 16 * (r >> 3); if (key > qabs) s0[r] = -INFINITY; if (key + 32 > qabs) s1[r] = -INFINITY; }
            }
            float mx = fmaxf(s0[0], s1[0]);
#pragma unroll
            for (int r = 1; r < 16; ++r) mx = fmaxf(mx, fmaxf(s0[r], s1[r]));
            mx = fmaxf(mx, lane_partner(mx, hi));
            const float mnew = fmaxf(mrun, mx), alpha = ex2(mrun - mnew);
            float ls = 0.f;
#pragma unroll
            for (int r = 0; r < 16; ++r) { s0[r] = ex2(s0[r] - mnew); s1[r] = ex2(s1[r] - mnew); ls += s0[r] + s1[r]; }
            lrun = lrun * alpha + ls; mrun = mnew;
#pragma unroll
            for (int r = 0; r < 16; ++r) { o0[r] *= alpha; o1[r] *= alpha; }
        } else {
            f32x16 b0, b1;
#pragma unroll
            for (int r = 0; r < 16; ++r) {
                { const float z = s0[r], sp = fmaxf(z, 0.f) + lg2(1.f + ex2(-fabsf(z))); b0[r] = -sp; s0[r] = z - sp; }
                { const float z = s1[r], sp = fmaxf(z, 0.f) + lg2(1.f + ex2(-fabsf(z))); b1[r] = -sp; s1[r] = z - sp; }
            }
            if (band) {
#pragma unroll
                for (int r = 0; r < 16; ++r) { const int key = kbase + (r & 7) + 16 * (r >> 3);
                    if (key >= qabs) { b0[r] = 0.f; s0[r] = -INFINITY; } if (key + 32 >= qabs) { b1[r] = 0.f; s1[r] = -INFINITY; } }
            }
            float T[4];
#pragma unroll
            for (int a = 0; a < 4; ++a) { float tt = 0.f;
#pragma unroll
                for (int e = 0; e < 8; ++e) tt += (a < 2 ? b0[8 * (a & 1) + e] : b1[8 * (a & 1) + e]);
                T[a] = tt; }
            float U[4], tot[4];
#pragma unroll
            for (int a = 0; a < 4; ++a) { U[a] = lane_partner(T[a], hi); tot[a] = T[a] + U[a]; }
            float later = carry;
#pragma unroll
            for (int a = 3; a >= 0; --a) {
                float run = later + (hi == 0 ? U[a] : 0.f);
#pragma unroll
                for (int e = 7; e >= 0; --e) {
                    if (a < 2) { const float lb = b0[8 * (a & 1) + e]; s0[8 * (a & 1) + e] = ex2(s0[8 * (a & 1) + e] + run); run += lb; }
                    else       { const float lb = b1[8 * (a & 1) + e]; s1[8 * (a & 1) + e] = ex2(s1[8 * (a & 1) + e] + run); run += lb; }
                }
                later += tot[a];
            }
            carry = later;
        }
        bf16x8 P[4];
#pragma unroll
        for (int ii = 0; ii < 4; ++ii) { u32x4 w;
            if (ii < 2) { w.x = cvtpk(s0[8 * ii], s0[8 * ii + 1]); w.y = cvtpk(s0[8 * ii + 2], s0[8 * ii + 3]); w.z = cvtpk(s0[8 * ii + 4], s0[8 * ii + 5]); w.w = cvtpk(s0[8 * ii + 6], s0[8 * ii + 7]); }
            else { const int i2 = ii - 2; w.x = cvtpk(s1[8 * i2], s1[8 * i2 + 1]); w.y = cvtpk(s1[8 * i2 + 2], s1[8 * i2 + 3]); w.z = cvtpk(s1[8 * i2 + 4], s1[8 * i2 + 5]); w.w = cvtpk(s1[8 * i2 + 6], s1[8 * i2 + 7]); }
            P[ii] = __builtin_bit_cast(bf16x8, w); }
#pragma unroll
        for (int ii = 0; ii < 4; ++ii) {
            const bf16x8 v0 = *(const LAS bf16x8*)(vb + voff + ii * 32), v1 = *(const LAS bf16x8*)(vb + 32 * A_ROWB + voff + ii * 32);
            o0 = __builtin_amdgcn_mfma_f32_32x32x16_bf16(v0, P[ii], o0, 0, 0, 0);
            o1 = __builtin_amdgcn_mfma_f32_32x32x16_bf16(v1, P[ii], o1, 0, 0, 0);
        }
        if (i + 1 < NT) A_WRITE(buf ^ 1);
        if (MODE == 1) {
            const bool done_w = __all(carry < -160.f);
            if (lane == 0) *(LAS unsigned*)(lds + A_OFF_FLAG + (i & 1) * 32 + wid * 4) = done_w ? 1u : 0u;
        }
        __syncthreads();
        if (MODE == 1) {
            const u32x4 f0 = *(const LAS u32x4*)(lds + A_OFF_FLAG + (i & 1) * 32), f1 = *(const LAS u32x4*)(lds + A_OFF_FLAG + (i & 1) * 32 + 16);
            if ((f0.x & f0.y & f0.z & f0.w & f1.x & f1.y & f1.z & f1.w) != 0u) break;
        }
    }
    float inv = 1.f;
    if (MODE == 0) { const float lt = lrun + lane_partner(lrun, hi); inv = 1.f / lt; }
    bf16* Ow = O + (rowbase + qabs) * D + h * 64 + 4 * hi;
#pragma unroll
    for (int g = 0; g < 4; ++g) {
        u32x2 w0, w1;
        w0.x = cvtpk(o0[4 * g] * inv, o0[4 * g + 1] * inv); w0.y = cvtpk(o0[4 * g + 2] * inv, o0[4 * g + 3] * inv);
        w1.x = cvtpk(o1[4 * g] * inv, o1[4 * g + 1] * inv); w1.y = cvtpk(o1[4 * g + 2] * inv, o1[4 * g + 3] * inv);
        *(u32x2*)(Ow + 8 * g) = w0; *(u32x2*)(Ow + 32 + 8 * g) = w1;
    }
#undef A_TILE
#undef A_LOAD
#undef A_WRITE
}

template <int MODE>
__device__ __forceinline__ void attn_phase(int vcu, int G, const bf16* Q, const bf16* K, const bf16* VT, const float* C2, bf16* O, LAS unsigned char* lds) {
    for (int v = vcu; v < 256; v += G) {
        const int bh = v >> 1, s = v & 1;
        for (int i = 0; i < 8; ++i) { const int jj = 2 * (i >> 1) + s; const int qb = (i & 1) ? 15 - jj : jj;
            attn_unit<MODE>(bh / NH, bh % NH, qb, Q, K, VT, C2, O, lds); }
    }
}
struct Args { const float* in[13]; float* out; unsigned char* ws; };

__device__ __forceinline__ void transpose_item(const float* W, int ldw, int k0, int n0, bf16* WT, int K, int drow0, LAS float* scr, int lane) {
#pragma unroll 8
    for (int i = 0; i < 32; ++i) { const int kk = 2 * i + (lane >> 5); scr[kk * 33 + (lane & 31)] = W[(size_t)(k0 + kk) * ldw + n0 + (lane & 31)]; }
    asm volatile("s_waitcnt lgkmcnt(0)" ::: "memory");
    const int c = lane & 7;
#pragma unroll
    for (int j = 0; j < 4; ++j) { const int n = (lane >> 3) + 8 * j; const LAS float* s = scr + (8 * c) * 33 + n;
        u32x4 o; o.x = cvtpk(s[0], s[33]); o.y = cvtpk(s[2 * 33], s[3 * 33]); o.z = cvtpk(s[4 * 33], s[5 * 33]); o.w = cvtpk(s[6 * 33], s[7 * 33]);
        *(u32x4*)(WT + (size_t)(drow0 + n) * K + k0 + 8 * c) = o; }
    asm volatile("s_waitcnt lgkmcnt(0)" ::: "memory");
}

#define PIN(T, i) ((T*)ldptr(lds, (i)))
__device__ __forceinline__ void* ldptr(LAS unsigned char* lds, int i) {
    const u32x2 v = *(const LAS u32x2*)(lds + PTAB_OFF + 8 * i);
    const unsigned long long p = ((unsigned long long)(unsigned)__builtin_amdgcn_readfirstlane((int)v.y) << 32) | (unsigned)__builtin_amdgcn_readfirstlane((int)v.x);
    return (void*)(__attribute__((address_space(1))) char*)p; }
__device__ __forceinline__ void prologue(LAS unsigned char* lds, int gw, int NGW, int wave, int lane) {
    unsigned char* a_ws = PIN(unsigned char, 14);
    LAS float* scr = (LAS float*)(lds + wave * 16384);
    constexpr int I_QKV = 16 * 96, I_O = 16 * 32, I_UP = 16 * 176, I_DN = 44 * 32, I_L = I_QKV + I_O + I_UP + I_DN;
    for (int it = gw; it < DEPTH * I_L; it += NGW) {
        const int l = it / I_L; int r = it % I_L; const int j = l >> 1; const bool fox = !(l & 1);
        bf16* wl = (bf16*)(a_ws + WS_W + (size_t)l * W_LAYER);
        if (r < I_QKV) { const int kb = r / 96, n0 = 32 * (r % 96);
            const float* W = fox ? PIN(const float, 4) + (size_t)j * D * 3088 : PIN(const float, 7) + (size_t)j * D * 3072; const int ldw = fox ? 3088 : 3072;
            if (n0 < 2048) transpose_item(W, ldw, 64 * kb, n0, wl + WO_QK / 2, D, n0, scr, lane);
            else transpose_item(W, ldw, 64 * kb, n0, wl + WO_V / 2, D, n0 - 2048, scr, lane);
            continue; }
        r -= I_QKV;
        if (r < I_O) { const int kb = r / 32, n0 = 32 * (r % 32); const float* W = (fox ? PIN(const float, 6) : PIN(const float, 8)) + (size_t)j * D * D;
            transpose_item(W, D, 64 * kb, n0, wl + WO_O / 2, D, n0, scr, lane); continue; }
        r -= I_O;
        if (r < I_UP) { const int kb = r / 176, c = 32 * (r % 176); const int drow0 = c < FF ? 256 * (c / 128) + (c % 128) : 256 * ((c - FF) / 128) + 128 + ((c - FF) % 128);
            transpose_item(PIN(const float, 9) + (size_t)l * D * FF2, FF2, 64 * kb, c, wl + WO_UP / 2, D, drow0, scr, lane); continue; }
        r -= I_UP;
        { const int kb = r / 32, n0 = 32 * (r % 32); transpose_item(PIN(const float, 12) + (size_t)l * FF * D, D, 64 * kb, n0, wl + WO_DN / 2, FF, n0, scr, lane); }
    }
}

template <bool FOX>
__device__ __forceinline__ void norm_phase(const float* src, const float* gain, bf16* xn, const float* Wf, const float* bfp, float* flog, LAS unsigned char* lds, int vcu, int G) {
    int tid = threadIdx.x; asm volatile("" : "+v"(tid));
    const int lane = tid & 63, gw = vcu * NWAVES + (tid >> 6), NGW = G * NWAVES;
    LAS float* wf = (LAS float*)lds;
    if (FOX) {
        for (int k = tid; k < D; k += NTHR) { const f32x4* p = (const f32x4*)(Wf + (size_t)k * 3088 + 3072);
#pragma unroll
            for (int q = 0; q < 4; ++q) { const f32x4 w = p[q];
#pragma unroll
                for (int e = 0; e < 4; ++e) wf[(4 * q + e) * 1024 + k] = w[e]; } }
        __syncthreads();
    }
    f32x4 g[4];
#pragma unroll
    for (int j = 0; j < 4; ++j) g[j] = ((const f32x4*)gain)[lane + 64 * j];
    for (int m = gw; m < M; m += NGW) {
        const f32x4* xr = (const f32x4*)(src + (size_t)m * D) + lane;
        f32x4 v[4]; float s = 0.f;
#pragma unroll
        for (int j = 0; j < 4; ++j) { v[j] = xr[64 * j]; s += (v[j].x * v[j].x + v[j].y * v[j].y) + (v[j].z * v[j].z + v[j].w * v[j].w); }
        const float rstd = 1.0f / sqrtf(wave_sum(s) * (1.f / D) + NORM_EPS);
        u32x2* o8 = (u32x2*)(xn + (size_t)m * D) + lane;
#pragma unroll
        for (int j = 0; j < 4; ++j) { v[j] = v[j] * rstd * g[j]; u32x2 w; w.x = cvtpk(v[j].x, v[j].y); w.y = cvtpk(v[j].z, v[j].w); o8[64 * j] = w; }
        if (FOX) {
            float mine = 0.f; int lane_l = lane; asm volatile("" : "+v"(lane_l));
#pragma unroll
            for (int hh = 0; hh < 16; ++hh) { float acc = 0.f;
#pragma unroll
                for (int j = 0; j < 4; ++j) { const f32x4 w = *(const LAS f32x4*)(wf + hh * 1024 + 256 * j + 4 * lane); acc += (v[j].x * w.x + v[j].y * w.y) + (v[j].z * w.z + v[j].w * w.w); }
                acc = wave_sum(acc); mine = (lane_l == hh) ? acc : mine; }
            if (lane < 16) { const float x2 = (mine + bfp[lane]) * LOG2E; flog[(size_t)m * 16 + lane] = fminf(x2, 0.f) - lg2(1.f + ex2(-fabsf(x2))); }
        }
    }
    if (FOX) __syncthreads();
}

__device__ __forceinline__ void scan_phase(const float* flog, float* c2, LAS unsigned char* lds, int G) {
    int tid = threadIdx.x; asm volatile("" : "+v"(tid));
    const int lane = tid & 63, wave = tid >> 6;
    LAS float* wsum = (LAS float*)(lds + MISC_OFF);
    for (int bh = blockIdx.x; bh < BATCH * NH; bh += G) {
        const int b = bh / NH, h = bh % NH;
        float v[8]; float run = 0.f;
#pragma unroll
        for (int i = 0; i < 8; ++i) { run += flog[((size_t)b * SEQ + 8 * tid + i) * 16 + h]; v[i] = run; }
        float incl = run;
#pragma unroll
        for (int o = 1; o < 64; o <<= 1) { const float nb = __shfl_up(incl, o); if (lane >= o) incl += nb; }
        if (lane == 63) wsum[wave] = incl;
        __syncthreads();
        float woff = 0.f;
#pragma unroll
        for (int w = 0; w < NWAVES; ++w) woff += (w < wave) ? wsum[w] : 0.f;
        const float excl = incl - run + woff;
        f32x4 o0 = (f32x4){v[0] + excl, v[1] + excl, v[2] + excl, v[3] + excl}, o1 = (f32x4){v[4] + excl, v[5] + excl, v[6] + excl, v[7] + excl};
        f32x4* dst = (f32x4*)(c2 + (size_t)bh * SEQ + 8 * tid); dst[0] = o0; dst[1] = o1;
        __syncthreads();
    }
}

__device__ __forceinline__ void fixup_phase(const float* edge, const float* raw01, const float* wconv, const float* bconv, bf16* act, int bx, int G) {
    int tid = threadIdx.x; asm volatile("" : "+v"(tid));
    const int gtid = bx * NTHR + tid, NGT = G * NTHR;
    for (int idx = gtid; idx < (M / 256) * 2 * FF; idx += NGT) {
        const int c = idx % FF, rr = (idx / FF) & 1, pm = idx / (2 * FF);
        const bool has = (pm % (SEQ / 256)) != 0;
        float r[2];
#pragma unroll
        for (int s = 0; s < 2; ++s) { const int col = s * FF + c;
            const float h0 = raw01[((size_t)pm * 2 + rr) * FF2 + col];
            const float e1 = has ? edge[((size_t)(pm - 1) * 2 + 1) * FF2 + col] : 0.f, e0 = has ? edge[((size_t)(pm - 1) * 2 + 0) * FF2 + col] : 0.f;
            const float hm1 = rr == 0 ? e1 : raw01[((size_t)pm * 2 + 0) * FF2 + col], hm2 = rr == 0 ? e0 : e1;
            r[s] = bconv[col] + wconv[2 * FF2 + col] * h0 + wconv[FF2 + col] * hm1 + wconv[col] * hm2; }
        const float sg = r[1] * __builtin_amdgcn_rcpf(1.f + ex2(-r[1] * LOG2E));
        act[(size_t)(pm * 256 + rr) * FF + c] = (bf16)(cvtpk(sg * r[0], 0.f) & 0xffffu);
    }
}


#ifndef DBG_STAGE
#define DBG_STAGE 0
#endif
#ifndef DBG_SKIP
#define DBG_SKIP 0
#endif
#ifndef DBG_FRAC
#define DBG_FRAC 1
#endif
__device__ __forceinline__ void dbg_dump_bf16(const bf16* src, float* out, int bx, int G) {
    int tid = threadIdx.x; asm volatile("" : "+v"(tid));
    for (size_t i = (size_t)bx * NTHR + tid; i < (size_t)M * D; i += (size_t)G * NTHR) { float v = __uint_as_float((unsigned)src[i] << 16); if (!(fabsf(v) < 1e30f)) v = 10000.f; out[i] = v; }
}

__device__ __forceinline__ float bf2f(bf16 v) { return __uint_as_float((unsigned)v << 16); }
__device__ __forceinline__ unsigned hash32(unsigned x) { x ^= x >> 16; x *= 0x7feb352du; x ^= x >> 15; x *= 0x846ca68bu; x ^= x >> 16; return x; }
__device__ __forceinline__ void dbg_acc(float* word, float got, float exp_) { const float d = fabsf(got - exp_) / (fabsf(exp_) + 0.05f); atomicMax((unsigned*)word, __float_as_uint(d)); }
__device__ __forceinline__ void dbg_check_qkv(const bf16* xn, const float* W  , const bf16* q, const bf16* k, const bf16* vt, float* word, int bx, int G) {
    int tid = threadIdx.x; asm volatile("" : "+v"(tid));
    const unsigned sidx = bx * NTHR + tid; if (sidx >= 16384u) return;
    const unsigned hsh = hash32(sidx * 2654435761u + 12345u); const int row = hsh % M, col = (hsh >> 15) % 3072;
    float acc = 0.f; for (int kk = 0; kk < D; ++kk) acc += bf2f(xn[(size_t)row * D + kk]) * W[(size_t)kk * 3088 + col];
    float got; if (col < 1024) { got = bf2f(q[(size_t)row * D + col]); acc *= QSCALE; } else if (col < 2048) got = bf2f(k[(size_t)row * D + col - 1024]); else got = bf2f(vt[(size_t)(col - 2048) * M + row]);
    dbg_acc(word, got, acc);
}
__device__ __forceinline__ void dbg_check_act(const bf16* xn, const float* Wup  , const float* wconv, const float* bconv, const bf16* act, float* word, int bx, int G, int mode) {
    int tid = threadIdx.x; asm volatile("" : "+v"(tid));
    const unsigned sidx = bx * NTHR + tid; if (sidx >= 16384u) return;
    const unsigned hsh = hash32(sidx * 2654435761u + 777u); int row = hsh % M; int c = (hsh >> 15) % FF;
    if (mode == 7) { row = (row & ~15) + 2 + (int)((hsh >> 27) % 12u); c = (c & ~127) + (int)((hsh >> 20) % 32u); }
    if (mode == 9) { row = (row & ~255 & ~(8 * 256)) + 2 + (int)((hsh >> 27) % 12u) + 16 * (int)((hsh >> 23) % 16u); c = c % 512; }
    if (mode == 8) { row = (row & ~255) + 2 + (int)((hsh >> 27) % 12u); }
    if (mode == 1) row = (row & ~255) + (sidx & 1);
    if (mode == 2) row = (row & ~63) + (sidx & 1);
    if (mode == 3) row = (row & ~15) + (sidx & 1);
    if (mode == 4) row = (row & ~15) + 2 + (int)((hsh >> 27) % 14u);
    if (mode == 5) row = (row & ~15) + 14 + (sidx & 1);
    if (mode == 6) row = (row & ~15) + 2 + (int)((hsh >> 27) % 12u);
    float hc[2];
    for (int s2 = 0; s2 < 2; ++s2) { const int col = s2 * FF + c; float tot = bconv[col];
        for (int tap = 0; tap < 3; ++tap) { const int r = row - 2 + tap; if ((r >> 12) != (row >> 12) || r < 0) continue;
            float acc = 0.f; for (int kk = 0; kk < D; ++kk) acc += bf2f(xn[(size_t)r * D + kk]) * Wup[(size_t)kk * FF2 + col];
            tot += wconv[tap * FF2 + col] * acc; }
        hc[s2] = tot; }
    const float exp_ = hc[0] * hc[1] / (1.f + __expf(-hc[1]));
    const float got_ = bf2f(act[(size_t)row * FF + c]);
    if (DBG_FRAC) { if (fabsf(got_ - exp_) > 0.1f * (fabsf(exp_) + 0.2f)) atomicAdd(word, 1.f / 16384.f); }
    else dbg_acc(word, got_, exp_);
}
__device__ __forceinline__ void dbg_check_attn(const bf16* q, const bf16* k, const bf16* vt, const float* c2, const bf16* o, float* word, int bx, int G, int mode) {
    int tid = threadIdx.x; asm volatile("" : "+v"(tid));
    const int lane = tid & 63; const unsigned sidx = bx * NWAVES + (tid >> 6); if (sidx >= 1024u) return;
    const unsigned hsh = hash32(sidx * 2654435761u + 99u); const int b = hsh % BATCH, h = (hsh >> 8) % NH; int qp = (hsh >> 14) % SEQ; if ((sidx & 7) == 0) qp = (qp & ~255) + (sidx >> 3) % 70;
    const size_t rb = (size_t)b * SEQ; const float qv = bf2f(q[(rb + qp) * D + h * 64 + lane]);
    float od = 0.f;
    if (mode == 0) {
        float mx = -INFINITY; for (int j = 0; j <= qp; ++j) { const float z = wave_sum(qv * bf2f(k[(rb + j) * D + h * 64 + lane])) - c2[((size_t)(b * NH + h)) * SEQ + j]; mx = fmaxf(mx, z); }
        float l = 0.f; for (int j = 0; j <= qp; ++j) { const float z = wave_sum(qv * bf2f(k[(rb + j) * D + h * 64 + lane])) - c2[((size_t)(b * NH + h)) * SEQ + j]; const float p = exp2f(z - mx); l += p; od += p * bf2f(vt[(size_t)(h * 64 + lane) * M + rb + j]); }
        od /= l;
    } else {
        float tail = 0.f; for (int j = qp - 1; j >= 0 && tail > -200.f; --j) { const float z = wave_sum(qv * bf2f(k[(rb + j) * D + h * 64 + lane]));
            const float sp = log2f(1.f + exp2f(z)); const float a = exp2f(z - sp + tail); tail -= sp; od += a * bf2f(vt[(size_t)(h * 64 + lane) * M + rb + j]); }
    }
    const float got = bf2f(o[(rb + qp) * D + h * 64 + lane]);
    const float d = fabsf(got - od) / (fabsf(od) + 0.02f); atomicMax((unsigned*)word, __float_as_uint(d));
}
__device__ __forceinline__ void dbg_check_resid(const float* base, const bf16* a, int K, const float* W, const float* hs, float* word, int bx, int G) {
    int tid = threadIdx.x; asm volatile("" : "+v"(tid));
    const unsigned sidx = bx * NTHR + tid; if (sidx >= 16384u) return;
    const unsigned hsh = hash32(sidx * 2654435761u + 4242u); const int row = hsh % M, col = (hsh >> 15) % D;
    float acc = 0.f; for (int kk = 0; kk < K; ++kk) acc += bf2f(a[(size_t)row * K + kk]) * W[(size_t)kk * D + col];
    const float exp_ = base[(size_t)row * D + col] + acc; dbg_acc(word, hs[(size_t)row * D + col], exp_);
}
#define DBG_BEGIN() do { if (bx0 == 0 && threadIdx.x == 0) *(float*)(PIN(unsigned char, 14) + WS_FLOG - 256) = 0.f; } while (0)
#define DBG_WORD ((float*)(PIN(unsigned char, 14) + WS_FLOG - 256))
#define DBG_FINISH() do { { int tz = threadIdx.x; asm volatile("" : "+v"(tz)); float* od_ = PIN(float, 13); for (size_t i = (size_t)bx0 * NTHR + tz; i < (size_t)M * D; i += (size_t)G0 * NTHR) od_[i] = 0.f; } GSYNC(); \
    if (bx0 == 0 && threadIdx.x == 0) PIN(float, 13)[0] = 10.f + 1000.f * *DBG_WORD; return; } while (0)
#define GSYNC() do { asm volatile("s_waitcnt vmcnt(0) lgkmcnt(0)" ::: "memory"); __builtin_amdgcn_fence(__ATOMIC_RELEASE, "agent"); grid.sync(); __builtin_amdgcn_fence(__ATOMIC_ACQUIRE, "agent"); } while (0)
__global__ void __launch_bounds__(NTHR, 2) fwd_kernel(Args a) {
    extern __shared__ __attribute__((aligned(16))) unsigned char lds_raw[];
    LAS unsigned char* lds = (LAS unsigned char*)lds_raw;
    cg::grid_group grid = cg::this_grid();
    const int tid = threadIdx.x, lane = tid & 63; const int wave = __builtin_amdgcn_readfirstlane(tid >> 6);
    const int G0 = gridDim.x, bx0 = blockIdx.x;
    const int vcu0 = (G0 % 8 == 0) ? (bx0 % 8) * (G0 / 8) + bx0 / 8 : bx0;
    if (tid == 0) {
#pragma unroll
        for (int i = 0; i < 13; ++i) *(LAS unsigned long long*)(lds + PTAB_OFF + 8 * i) = (unsigned long long)a.in[i];
        *(LAS unsigned long long*)(lds + PTAB_OFF + 8 * 13) = (unsigned long long)a.out; *(LAS unsigned long long*)(lds + PTAB_OFF + 8 * 14) = (unsigned long long)a.ws;
    }
    __syncthreads();
#define WSP(T, off) ((T*)(PIN(unsigned char, 14) + (off)))
#define XN WSP(bf16, WS_XN)
#define QO WSP(bf16, WS_QO)
#define KB WSP(bf16, WS_K)
#define VT WSP(bf16, WS_VT)
#define ACT WSP(bf16, WS_ACT)
#define FLOG WSP(float, WS_FLOG)
#define C2 WSP(float, WS_C2)
#define EDGE WSP(float, WS_EDGE)
#define RAW01 WSP(float, WS_RAW01)
#define HS PIN(float, 13)
#define XIN PIN(const float, 0)
    if (DBG_STAGE >= 30) DBG_BEGIN();
    prologue(lds, vcu0 * NWAVES + wave, G0 * NWAVES, wave, lane);
    __syncthreads();
    norm_phase<true>(XIN, PIN(const float, 1), XN, PIN(const float, 4), PIN(const float, 5), FLOG, lds, vcu0, G0);
    GSYNC();
    if (DBG_STAGE == 1) { dbg_dump_bf16(XN, HS, bx0, G0); return; }
    for (int l = 0; l < DEPTH; ++l) {
        const bool fox = !(l & 1); const int j = l >> 1;
        int G = G0, bx = bx0, vcu = vcu0; asm volatile("" : "+s"(G), "+s"(bx), "+s"(vcu));
        #define WL ((const bf16*)(PIN(unsigned char, 14) + WS_W + (size_t)l * W_LAYER))
        if (l > 0) {
            if (fox) norm_phase<true>(HS, PIN(const float, 1) + l * D, XN, PIN(const float, 4) + (size_t)j * D * 3088, PIN(const float, 5) + j * NH, FLOG, lds, vcu, G);
            else norm_phase<false>(HS, PIN(const float, 1) + l * D, XN, nullptr, nullptr, nullptr, lds, vcu, G);
            GSYNC();
        }
        if (fox) scan_phase(FLOG, C2, lds, G);
        { pg8::Gemm g{XN, WL + WO_QK / 2, M, 2048, D}; pg8::StaticOrder S; S.init(M, 2048, G, bx);
          pg8::EpiBf16<0> E{QO, D, nullptr, D, (size_t)(WS_K - WS_QO) / 2, QSCALE};
#ifndef NO_QK
          pg8::gemm_phase<pg8::EpiBf16<0>, pg8::StaticOrder, true, true>(lds, g, S, E);
#endif
        }
        { pg8::Gemm g{WL + WO_V / 2, XN, D, M, D}; pg8::StaticOrder S; S.init(D, M, G, bx);
          pg8::EpiBf16<0> E{VT, M, nullptr, 0, 0, 1.f};
#ifndef NO_VT
          pg8::gemm_phase<pg8::EpiBf16<0>, pg8::StaticOrder, true, true>(lds, g, S, E);
#endif
        }
        GSYNC();
        if (DBG_STAGE == 31 && l == 0) { dbg_check_qkv(XN, PIN(const float, 4), QO, KB, VT, DBG_WORD, bx, G); DBG_FINISH(); }
        if (DBG_STAGE == 32 && l == 0) { attn_phase<0>(vcu, G, QO, KB, VT, C2, XN, lds); GSYNC(); dbg_check_attn(QO, KB, VT, C2, XN, DBG_WORD, bx, G, 0); DBG_FINISH(); }
        if (DBG_STAGE == 35 && l == 1) { attn_phase<1>(vcu, G, QO, KB, VT, C2, XN, lds); GSYNC(); dbg_check_attn(QO, KB, VT, C2, XN, DBG_WORD, bx, G, 1); DBG_FINISH(); }
        if (DBG_STAGE == 2) { dbg_dump_bf16(QO, HS, bx, G); return; }
        if (DBG_STAGE == 3) { dbg_dump_bf16(KB, HS, bx, G); return; }
        if (DBG_STAGE == 4) { dbg_dump_bf16(VT, HS, bx, G); return; }
#ifndef NO_ATT0
        if (fox || DBG_STAGE == 10) attn_phase<0>(vcu, G, QO, KB, VT, C2, QO, lds);
#endif
#ifndef NO_ATT1
        if (!fox && DBG_STAGE != 10) attn_phase<1>(vcu, G, QO, KB, VT, C2, QO, lds);
#endif
        GSYNC();
        if (DBG_STAGE == 5) { dbg_dump_bf16(QO, HS, bx, G); return; }
        if (DBG_STAGE == 9 && l == 1) { dbg_dump_bf16(QO, HS, bx, G); return; }
        if ((DBG_SKIP & (fox ? 1 : 2)) != 0) {
            if (l == 0) { int tq = threadIdx.x; asm volatile("" : "+v"(tq)); const float* xs = XIN; float* hd = HS;
                for (size_t i = (size_t)bx * NTHR + tq; i < (size_t)M * D / 4; i += (size_t)G * NTHR) ((f32x4*)hd)[i] = ((const f32x4*)xs)[i]; }
        } else
        { pg8::Gemm g{QO, WL + WO_O / 2, M, D, D}; pg8::StaticOrder S; S.init(M, D, G, bx);
          EpiResid E{l == 0 ? XIN : HS, HS};
#ifndef NO_O
          pg8::gemm_phase<EpiResid, pg8::StaticOrder, true, true>(lds, g, S, E);
#endif
        }
        GSYNC();
        if (DBG_STAGE == 33 && l == 0) { dbg_check_resid(XIN, QO, D, PIN(const float, 6), HS, DBG_WORD, bx, G); DBG_FINISH(); }
        if (DBG_STAGE == 6) return;
        if ((DBG_SKIP & 4) != 0) continue;
        if ((DBG_STAGE == 8 || DBG_STAGE == 10) && l == 1) return;
        norm_phase<false>(HS, PIN(const float, 2) + l * D, XN, nullptr, nullptr, nullptr, lds, vcu, G);
        GSYNC();
        #define WCONV (PIN(const float, 10) + (size_t)l * 3 * FF2)
#define BCONV (PIN(const float, 11) + (size_t)l * FF2)
        { pg8::Gemm g{XN, WL + WO_UP / 2, M, FF2, D}; pg8::StaticOrder S; S.init(M, FF2, G, bx);
          EpiConvGate E{ACT, WCONV, BCONV, EDGE, RAW01, (LAS float*)(lds + XCH_OFF)};
#ifndef NO_UP
          pg8::gemm_phase<EpiConvGate, pg8::StaticOrder, true, true>(lds, g, S, E);
#endif
        }
        GSYNC();
        fixup_phase(EDGE, RAW01, WCONV, BCONV, ACT, bx, G);
        GSYNC();
        if (DBG_STAGE >= 40 && DBG_STAGE <= 49 && l == 0) { dbg_check_act(XN, PIN(const float, 9), WCONV, BCONV, ACT, DBG_WORD, bx, G, DBG_STAGE - 40); DBG_FINISH(); }
        { pg8::Gemm g{ACT, WL + WO_DN / 2, M, D, FF}; pg8::StaticOrder S; S.init(M, D, G, bx);
          EpiResid E{HS, HS};
#ifndef NO_DN
          pg8::gemm_phase<EpiResid, pg8::StaticOrder, true, true>(lds, g, S, E);
#endif
        }
        GSYNC();        if (DBG_STAGE == 7) return;
    }
    {
        int tidf = threadIdx.x; asm volatile("" : "+v"(tidf));
        const int lane = tidf & 63, gw = vcu0 * NWAVES + (tidf >> 6), NGW = G0 * NWAVES;
        f32x4 g[4];
#pragma unroll
        for (int jq = 0; jq < 4; ++jq) g[jq] = ((const f32x4*)PIN(const float, 3))[lane + 64 * jq];
        float* hs_ = HS;
        for (int m = gw; m < M; m += NGW) {
            f32x4* xr = (f32x4*)(hs_ + (size_t)m * D) + lane;
            f32x4 v[4]; float s = 0.f;
#pragma unroll
            for (int jq = 0; jq < 4; ++jq) { v[jq] = xr[64 * jq]; s += (v[jq].x * v[jq].x + v[jq].y * v[jq].y) + (v[jq].z * v[jq].z + v[jq].w * v[jq].w); }
            const float rstd = 1.0f / sqrtf(wave_sum(s) * (1.f / D) + NORM_EPS);
#pragma unroll
            for (int jq = 0; jq < 4; ++jq) xr[64 * jq] = v[jq] * rstd * g[jq];
        }
    }
}

extern "C" void kernel_launch(void* const* d_in, const int* in_sizes, int n_in, void* d_out, int out_size, void* d_ws, size_t ws_size, hipStream_t stream) {
    static int grid = 0;
    if (grid == 0) {
        if (n_in != 13 || out_size != M * D || ws_size < WS_END) { fprintf(stderr, "kernel_launch: unexpected problem shape (n_in %d, out %d, ws %zu)\n", n_in, out_size, ws_size); grid = -1; return; }
        int dev = 0, cus = 0, per_cu = 0;
        (void)hipGetDevice(&dev); (void)hipDeviceGetAttribute(&cus, hipDeviceAttributeMultiprocessorCount, dev);
        if (hipFuncSetAttribute((const void*)fwd_kernel, hipFuncAttributeMaxDynamicSharedMemorySize, LDS_BYTES) != hipSuccess) { fprintf(stderr, "kernel_launch: hipFuncSetAttribute failed\n"); }
        if (hipOccupancyMaxActiveBlocksPerMultiprocessor(&per_cu, (const void*)fwd_kernel, NTHR, LDS_BYTES) != hipSuccess || per_cu < 1) { fprintf(stderr, "kernel_launch: occupancy query gave %d; using 1\n", per_cu); per_cu = 1; }
        (void)hipGetLastError();
        grid = cus * per_cu;
    }
    if (grid < 0) return;
    Args a{};
    for (int i = 0; i < 13; ++i) a.in[i] = (const float*)d_in[i];
    a.out = (float*)d_out; a.ws = (unsigned char*)d_ws;
    void* args[] = {&a};
    const hipError_t e = hipLaunchCooperativeKernel((const void*)fwd_kernel, dim3(grid), dim3(NTHR), args, LDS_BYTES, stream);
    if (e != hipSuccess) fprintf(stderr, "kernel_launch: cooperative launch failed: %s (grid %d)\n", hipGetErrorString(e), grid);
}
```

```cpp
#include <hip/hip_runtime.h>
#include <hip/hip_cooperative_groups.h>
#include <cstdio>
#include <cstdint>
namespace cg = cooperative_groups;
namespace pg8 {
#define PG8_LAS __attribute__((address_space(3)))
typedef unsigned short bf16_t;
typedef short bf16x8 __attribute__((ext_vector_type(8)));
typedef float f32x4 __attribute__((ext_vector_type(4)));
typedef unsigned u32x4 __attribute__((ext_vector_type(4)));
constexpr int BM = 256, BK = 64, HALF = 128, HTB = HALF * BK * 2  , STAGE_BYTES = 8 * HTB, NXCD = 8, WGM = 8;

__host__ __device__ __forceinline__ int lds_byte(int r, int c) { const int st = (r >> 4) * 2 + (c >> 5), rr = r & 15, cc = c & 31, ob = rr * 64 + cc * 2; return st * 1024 + (ob ^ (((ob >> 9) & 1) << 5)); }
__host__ __device__ __forceinline__ void stage_rc(int b, int& R, int& C) { const int st = b / 1024, sb = b % 1024, swz = sb ^ (((sb >> 9) & 1) << 5); R = (st >> 1) * 16 + swz / 64; C = (st & 1) * 32 + (swz % 64) / 2; }
__host__ __device__ __forceinline__ int perm32(int rho) { const int n = rho >> 4, i = rho & 15; return 8 * (i >> 2) + 4 * n + (i & 3); }

struct Unit { int pm, pn; };
struct Gemm { const bf16_t* A; const bf16_t* Bt; int M, N, K; };

struct StaticOrder {
    int nM, nN, nwg, G, c;
    __host__ __device__ void init(int M, int N, int G_, int c_) { nM = M / BM; nN = N / BM; nwg = nM * nN; G = G_; c = c_; }
    __host__ __device__ bool next(int i, Unit& u) const {
        const long L = (long)i * G + c; if (L >= nwg) return false;
        int wgid = (int)L; { const int q = nwg / NXCD, r = nwg % NXCD, xcd = wgid % NXCD, off = wgid / NXCD; wgid = (xcd < r ? xcd * (q + 1) : r * (q + 1) + (xcd - r) * q) + off; }
        const int nig = WGM * nN, gid = wgid / nig, fm = gid * WGM, gsz = (nM - fm) < WGM ? (nM - fm) : WGM;
        u.pm = fm + ((wgid % nig) % gsz); u.pn = (wgid % nig) / gsz; return true;
    }
    __device__ __forceinline__ void a_ready(const Unit&) const {}
    __device__ __forceinline__ void done(const Unit&) const {}
};

__device__ __forceinline__ unsigned cvt_pk_bf16(float lo, float hi) { unsigned r; asm volatile("v_cvt_pk_bf16_f32 %0, %1, %2" : "=v"(r) : "v"(lo), "v"(hi)); return r; }
typedef float f32x2 __attribute__((ext_vector_type(2)));
__device__ __forceinline__ f32x2 gelu_pk(f32x2 v) {
    const f32x2 av = __builtin_elementwise_abs(v), d = av * 0.2316418882f + 1.0f;
    f32x2 t; t.x = __builtin_amdgcn_rcpf(d.x); t.y = __builtin_amdgcn_rcpf(d.y);
    f32x2 q = t * 0.5307027145f + (-0.7265760135f); q = q * t + 0.7107068705f; q = q * t + (-0.142248368f); q = q * t + 0.127414796f; q = q * t;
    const f32x2 s = (v * v) * (-0.72134752044f);
    f32x2 e; e.x = __builtin_amdgcn_exp2f(s.x); e.y = __builtin_amdgcn_exp2f(s.y);
    const f32x2 m = v * (q * e), r = v - m;
    f32x2 o; o.x = v.x < 0.f ? m.x : r.x; o.y = v.y < 0.f ? m.y : r.y; return o;
}

template <int ACT  > struct EpiBf16 {
    static constexpr bool PERM = true, AFTER_DRAIN = false; static_assert(ACT == 0 || ACT == 1, "EpiBf16: ACT is 0 (none) or 1 (gelu_pk)");
    bf16_t* O; int ldc; const float* bias; int split_cols; size_t split_stride; float scale0;
    __device__ __forceinline__ void operator()(const f32x4 (&acc)[2][2][4][2], const Unit& u, int wr, int wc, int fr, int fq) const {
        const int row0 = u.pm * BM + wr * 64 + fr; int colt = u.pn * BM; bf16_t* base = O;
        float sc = 1.f; if (split_cols) { const int t = colt / split_cols; base += (size_t)t * split_stride; colt -= t * split_cols; if (t == 0) sc = scale0; }
        const int col0 = colt + wc * 32 + 8 * fq, bcol0 = u.pn * BM + wc * 32 + 8 * fq;
        f32x4 bv[2][2];
#pragma unroll
        for (int bj = 0; bj < 2; ++bj)
#pragma unroll
            for (int n = 0; n < 2; ++n) bv[bj][n] = bias ? *(const f32x4*)(bias + bcol0 + bj * HALF + 4 * n) : (f32x4){0.f, 0.f, 0.f, 0.f};
#pragma unroll
        for (int ai = 0; ai < 2; ++ai)
#pragma unroll
            for (int m = 0; m < 4; ++m) { bf16_t* rowp = base + (size_t)(row0 + ai * HALF + m * 16) * ldc + col0;
#pragma unroll
                for (int bj = 0; bj < 2; ++bj) { f32x4 v0 = acc[ai][bj][m][0] + bv[bj][0], v1 = acc[ai][bj][m][1] + bv[bj][1];
                    if (ACT == 1) { f32x2 a = gelu_pk((f32x2){v0[0], v0[1]}), b = gelu_pk((f32x2){v0[2], v0[3]}), c = gelu_pk((f32x2){v1[0], v1[1]}), d = gelu_pk((f32x2){v1[2], v1[3]});
                        v0 = (f32x4){a.x, a.y, b.x, b.y}; v1 = (f32x4){c.x, c.y, d.x, d.y}; }
                    v0 = v0 * sc; v1 = v1 * sc; u32x4 w; w.x = cvt_pk_bf16(v0[0], v0[1]); w.y = cvt_pk_bf16(v0[2], v0[3]); w.z = cvt_pk_bf16(v1[0], v1[1]); w.w = cvt_pk_bf16(v1[2], v1[3]);
                    *(u32x4*)(rowp + bj * HALF) = w; } }
    }
};
template <class Epi, class Sched, bool ALIGN_EPI = false, bool SP2 = false>
__device__ __forceinline__ void gemm_phase(PG8_LAS unsigned char* lds, const Gemm g, const Sched& S, const Epi& E) {
    int tid_ = threadIdx.x; asm volatile("" : "+v"(tid_));
    const int tid = tid_, wid = __builtin_amdgcn_readfirstlane(tid >> 6), lane = tid & 63, wr = wid >> 2, wc = wid & 3, fr = lane & 15, fq = lane >> 4;
    const int K = g.K, nt = K / BK;
    unsigned voffA[2], voffB[2];
#pragma unroll
    for (int i = 0; i < 2; ++i) { int R, C; stage_rc(tid * 16 + i * 8192, R, C); const int Rb = Epi::PERM ? ((R & ~31) + perm32(R & 31)) : R;
        voffA[i] = (unsigned)(R * K + C) * 2u; voffB[i] = (unsigned)(Rb * K + C) * 2u; }
    const size_t kstep = (size_t)(BK * 2);
    const size_t hstep = (size_t)HALF * K * 2;
    const size_t tstep = 2 * hstep;
    const unsigned ldsw = (unsigned)wid * 1024u;
    const int aoff = lds_byte(wr * 64 + fr, fq * 8), boff = lds_byte(wc * 32 + fr, fq * 8);
#define PG8_SA(b, h) (((b) * 2 + (h)) * HTB)
#define PG8_SB(b, h) ((4 + (b) * 2 + (h)) * HTB)
#define PG8_STAGE(bufoff, gbase, voff) do { _Pragma("unroll") for (int _i = 0; _i < 2; ++_i) \
        __builtin_amdgcn_global_load_lds((const unsigned*)((const char*)(gbase) + (voff)[_i]), (PG8_LAS unsigned*)(lds + (bufoff) + ldsw + _i * 8192), 16, 0, 0); } while (0)
#define PG8_LDA(dst, b, h) do { _Pragma("unroll") for (int m = 0; m < 4; ++m) _Pragma("unroll") for (int k = 0; k < 2; ++k) dst[m][k] = *(const PG8_LAS bf16x8*)(lds + PG8_SA(b, h) + aoff + m * 2048 + k * 1024); } while (0)
#define PG8_LDB(dst, b, h) do { _Pragma("unroll") for (int n = 0; n < 2; ++n) _Pragma("unroll") for (int k = 0; k < 2; ++k) dst[n][k] = *(const PG8_LAS bf16x8*)(lds + PG8_SB(b, h) + boff + n * 2048 + k * 1024); } while (0)
#define PG8_MMA(ai, bj, At, Bt) do { __builtin_amdgcn_s_setprio(1); _Pragma("unroll") for (int m = 0; m < 4; ++m) _Pragma("unroll") for (int n = 0; n < 2; ++n) _Pragma("unroll") for (int k = 0; k < 2; ++k) \
        acc[ai][bj][m][n] = __builtin_amdgcn_mfma_f32_16x16x32_bf16(Bt[n][k], At[m][k], acc[ai][bj][m][n], 0, 0, 0); __builtin_amdgcn_s_setprio(0); } while (0)
#define PG8_WAIT_V(n) asm volatile("s_waitcnt vmcnt(" #n ")" ::: "memory")
#define PG8_WAIT_L(n) asm volatile("s_waitcnt lgkmcnt(" #n ")" ::: "memory")
#define PG8_BAR __builtin_amdgcn_s_barrier()
#define PG8_SCHED __builtin_amdgcn_sched_barrier(0)
    Unit cur, nxt; int ui = 0;
    if (!S.next(0, cur)) return;
    f32x4 acc[2][2][4][2];
#pragma unroll
    for (int a = 0; a < 2; ++a)
#pragma unroll
        for (int b = 0; b < 2; ++b)
#pragma unroll
            for (int m = 0; m < 4; ++m)
#pragma unroll
                for (int n = 0; n < 2; ++n) acc[a][b][m][n] = (f32x4){0.f, 0.f, 0.f, 0.f};
    bf16x8 At[4][2], B0[2][2], B1[2][2];
    const char* cA = (const char*)g.A + (size_t)cur.pm * tstep; const char* cB = (const char*)g.Bt + (size_t)cur.pn * tstep;
    S.a_ready(cur);
    if constexpr (SP2) {
        PG8_STAGE(PG8_SB(0, 0), cB, voffB); PG8_STAGE(PG8_SB(0, 1), cB + hstep, voffB); PG8_STAGE(PG8_SA(0, 0), cA, voffA); PG8_STAGE(PG8_SA(0, 1), cA + hstep, voffA);
        if (wr == 1) PG8_BAR;
        PG8_WAIT_V(2); PG8_BAR;
        PG8_STAGE(PG8_SB(1, 0), cB + kstep, voffB); PG8_STAGE(PG8_SA(1, 0), cA + kstep, voffA); PG8_STAGE(PG8_SB(1, 1), cB + hstep + kstep, voffB);
        PG8_WAIT_V(6); PG8_BAR;
    } else {
        PG8_STAGE(PG8_SB(0, 0), cB, voffB); PG8_STAGE(PG8_SA(0, 0), cA, voffA); PG8_STAGE(PG8_SB(0, 1), cB + hstep, voffB); PG8_STAGE(PG8_SA(0, 1), cA + hstep, voffA);
        if (wr == 1) PG8_BAR;
        PG8_WAIT_V(4); PG8_BAR;
        PG8_STAGE(PG8_SB(1, 0), cB + kstep, voffB); PG8_STAGE(PG8_SA(1, 0), cA + kstep, voffA); PG8_STAGE(PG8_SB(1, 1), cB + hstep + kstep, voffB);
        PG8_WAIT_V(6); PG8_BAR;
    }
    for (;;) {
        const bool has_next = S.next(ui + 1, nxt);
        const char* nA = has_next ? (const char*)g.A + (size_t)nxt.pm * tstep : cA; const char* nB = has_next ? (const char*)g.Bt + (size_t)nxt.pn * tstep : cB;
        for (int t = 0; t < nt; t += 2) {
            const bool last = (t == nt - 2);
            const char* a1 = cA + (size_t)(t + 1) * kstep;
            const char* a2 = last ? nA : cA + (size_t)(t + 2) * kstep; const char* b2 = last ? nB : cB + (size_t)(t + 2) * kstep;
            const char* a3 = a2 + kstep; const char* b3 = b2 + kstep;
            if (last && has_next) S.a_ready(nxt);
            if constexpr (SP2) {
            PG8_LDB(B0, 0, 0); PG8_LDB(B1, 0, 1); PG8_SCHED; PG8_LDA(At, 0, 0); PG8_STAGE(PG8_SA(1, 1), a1 + hstep, voffA);
            PG8_WAIT_V(8); PG8_WAIT_L(0); PG8_BAR; PG8_MMA(0, 0, At, B0); PG8_MMA(0, 1, At, B1); PG8_BAR; PG8_SCHED;
            PG8_LDA(At, 0, 1); PG8_STAGE(PG8_SB(0, 0), b2, voffB); PG8_STAGE(PG8_SB(0, 1), b2 + hstep, voffB); PG8_STAGE(PG8_SA(0, 0), a2, voffA);
            PG8_WAIT_V(8); PG8_WAIT_L(0); PG8_BAR; PG8_MMA(1, 0, At, B0); PG8_MMA(1, 1, At, B1); PG8_BAR; PG8_SCHED;
            PG8_LDB(B0, 1, 0); PG8_LDB(B1, 1, 1); PG8_SCHED; PG8_LDA(At, 1, 0); PG8_STAGE(PG8_SA(0, 1), a2 + hstep, voffA);
            PG8_WAIT_V(8); PG8_WAIT_L(0); PG8_BAR; PG8_MMA(0, 0, At, B0); PG8_MMA(0, 1, At, B1); PG8_BAR; PG8_SCHED;
            PG8_LDA(At, 1, 1); PG8_STAGE(PG8_SB(1, 0), b3, voffB); PG8_STAGE(PG8_SB(1, 1), b3 + hstep, voffB); PG8_STAGE(PG8_SA(1, 0), a3, voffA);
            PG8_WAIT_V(8); PG8_WAIT_L(0); PG8_BAR; PG8_MMA(1, 0, At, B0); PG8_MMA(1, 1, At, B1); PG8_BAR; PG8_SCHED;
            } else {
            PG8_LDB(B0, 0, 0); PG8_SCHED; PG8_LDA(At, 0, 0); PG8_STAGE(PG8_SA(1, 1), a1 + hstep, voffA);
            PG8_WAIT_L(8); PG8_BAR; PG8_WAIT_L(0); PG8_MMA(0, 0, At, B0); PG8_BAR; PG8_SCHED;
            PG8_LDB(B1, 0, 1); PG8_STAGE(PG8_SB(0, 0), b2, voffB);
            PG8_BAR; PG8_WAIT_L(0); PG8_MMA(0, 1, At, B1); PG8_BAR;
            PG8_LDA(At, 0, 1); PG8_STAGE(PG8_SA(0, 0), a2, voffA);
            PG8_BAR; PG8_WAIT_L(0); PG8_MMA(1, 0, At, B0); PG8_BAR; PG8_SCHED;
            PG8_STAGE(PG8_SB(0, 1), b2 + hstep, voffB);
            PG8_WAIT_V(6); PG8_BAR; PG8_MMA(1, 1, At, B1); PG8_BAR;
            PG8_LDB(B0, 1, 0); PG8_SCHED; PG8_LDA(At, 1, 0); PG8_STAGE(PG8_SA(0, 1), a2 + hstep, voffA);
            PG8_WAIT_L(8); PG8_BAR; PG8_WAIT_L(0); PG8_MMA(0, 0, At, B0); PG8_BAR; PG8_SCHED;
            PG8_LDB(B1, 1, 1); PG8_STAGE(PG8_SB(1, 0), b3, voffB);
            PG8_BAR; PG8_WAIT_L(0); PG8_MMA(0, 1, At, B1); PG8_BAR;
            PG8_LDA(At, 1, 1); PG8_STAGE(PG8_SA(1, 0), a3, voffA);
            PG8_BAR; PG8_WAIT_L(0); PG8_MMA(1, 0, At, B0); PG8_BAR; PG8_SCHED;
            PG8_STAGE(PG8_SB(1, 1), b3 + hstep, voffB);
            PG8_WAIT_V(6); PG8_BAR; PG8_MMA(1, 1, At, B1); PG8_BAR;
            }
        }
        if constexpr (ALIGN_EPI) { if (wr == 0) PG8_BAR; }
        if constexpr (!Epi::AFTER_DRAIN) { E(acc, cur, wr, wc, fr, fq); S.done(cur); }
        if (!has_next) break;
#pragma unroll
        for (int a = 0; a < 2; ++a)
#pragma unroll
            for (int b = 0; b < 2; ++b)
#pragma unroll
                for (int m = 0; m < 4; ++m)
#pragma unroll
                    for (int n = 0; n < 2; ++n) acc[a][b][m][n] = (f32x4){0.f, 0.f, 0.f, 0.f};
        cur = nxt; cA = nA; cB = nB; ++ui;
        if constexpr (ALIGN_EPI) { if (wr == 1) PG8_BAR; }
    }
    PG8_WAIT_V(0);
    if constexpr (!ALIGN_EPI) { if (wr == 0) PG8_BAR; }
    PG8_BAR;
    if constexpr (Epi::AFTER_DRAIN) { E.fused(acc, cur, wr, wc, fr, fq, lds, wid, lane); S.done(cur); }
#undef PG8_SA
#undef PG8_SB
#undef PG8_STAGE
#undef PG8_LDA
#undef PG8_LDB
#undef PG8_MMA
#undef PG8_WAIT_V
#undef PG8_WAIT_L
#undef PG8_BAR
#undef PG8_SCHED
}
}
#ifndef DBG_STAGE
#define DBG_STAGE 0
#endif
#ifndef DBG_SKIP
#define DBG_SKIP 0
#endif
constexpr int BATCH = 8, SEQ = 4096, D = 1024, NH = 16, HD = 64, FF = 2816, FF2 = 2 * FF, DEPTH = 4;
constexpr int M = BATCH * SEQ;
constexpr float NORM_EPS = 1e-6f;
constexpr float LOG2E = 1.4426950408889634f;
constexpr float QSCALE = 0.125f * LOG2E;
constexpr int NWAVES = 8, NTHR = 512;

#define LAS __attribute__((address_space(3)))
typedef unsigned short bf16;
typedef float f32x4 __attribute__((ext_vector_type(4)));
typedef float f32x16 __attribute__((ext_vector_type(16)));
typedef short bf16x8 __attribute__((ext_vector_type(8)));
typedef unsigned u32x4 __attribute__((ext_vector_type(4)));
typedef unsigned u32x2 __attribute__((ext_vector_type(2)));

constexpr size_t MiB = 1u << 20;
constexpr size_t W_LAYER = 25 * MiB;
constexpr size_t WO_QK = 0, WO_V = 4 * MiB, WO_O = 6 * MiB, WO_UP = 8 * MiB, WO_DN = 19 * MiB;
constexpr size_t WS_W = 0;
constexpr size_t WS_BAR = 99 * MiB + 576 * 1024;
constexpr size_t WS_FLOG = 100 * MiB;
constexpr size_t WS_C2 = 102 * MiB;
constexpr size_t WS_EDGE = 104 * MiB;
constexpr size_t WS_RAW01 = 110 * MiB;
constexpr size_t WS_XN = 116 * MiB;
constexpr size_t WS_QO = 180 * MiB;
constexpr size_t WS_K = 244 * MiB;
constexpr size_t WS_VT = 308 * MiB;
constexpr size_t WS_ACT = 180 * MiB;
constexpr size_t WS_HSB = 372 * MiB;
constexpr size_t WS_END = 436 * MiB;
static_assert(WS_ACT + (size_t)M * FF * 2 <= WS_END, "ws map");

constexpr int RING_BYTES = 131072, XCH_OFF = RING_BYTES, MISC_OFF = XCH_OFF + 8192, PTAB_OFF = MISC_OFF + 256, TIME_OFF = MISC_OFF + 512, WL_OFF = MISC_OFF + 1024, LDS_BYTES = 147456;

typedef float f32x2_t __attribute__((ext_vector_type(2))); typedef __bf16 bf16x2_t __attribute__((ext_vector_type(2)));
__device__ __forceinline__ unsigned cvtpk(float lo, float hi) { f32x2_t v = {lo, hi}; bf16x2_t b = __builtin_convertvector(v, bf16x2_t); return __builtin_bit_cast(unsigned, b); }
__device__ __forceinline__ float wave_sum(float v) {
#pragma unroll
    for (int o = 1; o < 64; o <<= 1) v += __shfl_xor(v, o);
    return v;
}
__device__ __forceinline__ float ex2(float x) { return __builtin_amdgcn_exp2f(x); }
__device__ __forceinline__ float lg2(float x) { return __builtin_amdgcn_logf(x); }
__device__ __forceinline__ float bflo(unsigned w) { return __uint_as_float(w << 16); }
__device__ __forceinline__ float bfhi(unsigned w) { return __uint_as_float(w & 0xffff0000u); }
template <bool BASE_F32>
struct EpiResid {
    static constexpr bool PERM = true, AFTER_DRAIN = false;
    const void* base; bf16* out;
    __device__ __forceinline__ void operator()(const pg8::f32x4 (&acc)[2][2][4][2], const pg8::Unit& u, int wr, int wc, int fr, int fq) const {
        const int row0 = u.pm * 256 + wr * 64 + fr, col0 = u.pn * 256 + wc * 32 + 8 * fq;
#pragma unroll
        for (int ai = 0; ai < 2; ++ai)
#pragma unroll
            for (int m = 0; m < 4; ++m) { const size_t off = (size_t)(row0 + ai * 128 + m * 16) * D + col0;
#pragma unroll
                for (int bj = 0; bj < 2; ++bj) { f32x4 b0, b1;
                    if (BASE_F32) { b0 = *(const f32x4*)((const float*)base + off + bj * 128); b1 = *(const f32x4*)((const float*)base + off + bj * 128 + 4); }
                    else { const u32x4 w = *(const u32x4*)((const bf16*)base + off + bj * 128); b0 = (f32x4){bflo(w.x), bfhi(w.x), bflo(w.y), bfhi(w.y)}; b1 = (f32x4){bflo(w.z), bfhi(w.z), bflo(w.w), bfhi(w.w)}; }
                    const f32x4 r0 = b0 + acc[ai][bj][m][0], r1 = b1 + acc[ai][bj][m][1];
                    u32x4 o; o.x = cvtpk(r0[0], r0[1]); o.y = cvtpk(r0[2], r0[3]); o.z = cvtpk(r1[0], r1[1]); o.w = cvtpk(r1[2], r1[3]);
                    *(u32x4*)(out + off + bj * 128) = o; }
                asm volatile("" ::: "memory"); }
    }
};

__device__ __forceinline__ float dpp_ror1(float v) { return __builtin_bit_cast(float, __builtin_amdgcn_mov_dpp(__builtin_bit_cast(int, v), 0x121, 0xf, 0xf, false)); }
__device__ __forceinline__ float dpp_shr1_old(float old_, float v) { return __builtin_bit_cast(float, __builtin_amdgcn_update_dpp(__builtin_bit_cast(int, old_), __builtin_bit_cast(int, v), 0x111, 0xf, 0xf, false)); }
__device__ __forceinline__ float dpp_shr2_old(float old_, float v) { return __builtin_bit_cast(float, __builtin_amdgcn_update_dpp(__builtin_bit_cast(int, old_), __builtin_bit_cast(int, v), 0x112, 0xf, 0xf, false)); }
__device__ __forceinline__ float dpp_ror2(float v) { return __builtin_bit_cast(float, __builtin_amdgcn_mov_dpp(__builtin_bit_cast(int, v), 0x122, 0xf, 0xf, false)); }

struct EpiConvGate {
    static constexpr bool PERM = true, AFTER_DRAIN = false;
    bf16* act; const float* wconv; const float* bconv; float* edge; float* raw01; LAS float* xch;
    __device__ __forceinline__ void operator()(const pg8::f32x4 (&acc)[2][2][4][2], const pg8::Unit& u, int wr, int wc, int fr, int fq) const {
        const int lc0 = wc * 32 + 8 * fq, ch0 = u.pn * 128 + lc0;
        if (fr >= 14) {
#pragma unroll
            for (int ai = 0; ai < 2; ++ai) { const int q = 2 * ai + wr;
#pragma unroll
                for (int bj = 0; bj < 2; ++bj)
#pragma unroll
                    for (int n = 0; n < 2; ++n) *(LAS f32x4*)(xch + (q * 2 + (fr - 14)) * 256 + bj * 128 + lc0 + 4 * n) = acc[ai][bj][3][n]; }
            if (wr == 1) {
#pragma unroll
                for (int bj = 0; bj < 2; ++bj)
#pragma unroll
                    for (int n = 0; n < 2; ++n) *(f32x4*)(edge + ((size_t)u.pm * 2 + (fr - 14)) * FF2 + bj * FF + ch0 + 4 * n) = acc[1][bj][3][n]; }
        }
        if (wr == 0 && fr < 2) {
#pragma unroll
            for (int bj = 0; bj < 2; ++bj)
#pragma unroll
                for (int n = 0; n < 2; ++n) *(f32x4*)(raw01 + ((size_t)u.pm * 2 + fr) * FF2 + bj * FF + ch0 + 4 * n) = acc[0][bj][0][n];
        }
        asm volatile("s_waitcnt lgkmcnt(0)" ::: "memory"); __builtin_amdgcn_s_barrier(); asm volatile("" ::: "memory");
#pragma unroll
        for (int n = 0; n < 2; ++n) {
            const f32x4 wu0 = *(const f32x4*)(wconv + ch0 + 4 * n), wu1 = *(const f32x4*)(wconv + FF2 + ch0 + 4 * n), wu2 = *(const f32x4*)(wconv + 2 * FF2 + ch0 + 4 * n), bu = *(const f32x4*)(bconv + ch0 + 4 * n);
            const f32x4 wg0 = *(const f32x4*)(wconv + FF + ch0 + 4 * n), wg1 = *(const f32x4*)(wconv + FF2 + FF + ch0 + 4 * n), wg2 = *(const f32x4*)(wconv + 2 * FF2 + FF + ch0 + 4 * n), bg = *(const f32x4*)(bconv + FF + ch0 + 4 * n);
#pragma unroll
            for (int ai = 0; ai < 2; ++ai) {
                const int q = 2 * ai + wr;
                f32x4 pru = (f32x4){0.f, 0.f, 0.f, 0.f}, prg = pru;
                if (q > 0 && fr >= 14) { pru = *(const LAS f32x4*)(xch + ((q - 1) * 2 + (fr - 14)) * 256 + lc0 + 4 * n); prg = *(const LAS f32x4*)(xch + ((q - 1) * 2 + (fr - 14)) * 256 + 128 + lc0 + 4 * n); }
#pragma unroll
                for (int m = 0; m < 4; ++m) {
                    float r4[4];
#pragma unroll
                    for (int j = 0; j < 4; ++j) {
                        const float vu = acc[ai][0][m][n][j], vg = acc[ai][1][m][n][j];
                        const float pu = m > 0 ? acc[ai][0][m > 0 ? m - 1 : 0][n][j] : pru[j];
                        const float pg = m > 0 ? acc[ai][1][m > 0 ? m - 1 : 0][n][j] : prg[j];
                        const float u1 = dpp_shr1_old(dpp_ror1(pu), vu), u2 = dpp_shr2_old(dpp_ror2(pu), vu);
                        const float g1 = dpp_shr1_old(dpp_ror1(pg), vg), g2 = dpp_shr2_old(dpp_ror2(pg), vg);
                        const float nb = (DBG_STAGE == 21) ? 0.f : 1.f;
                        const float hu = bu[j] + wu2[j] * vu + nb * (wu1[j] * u1 + wu0[j] * u2);
                        const float hg = bg[j] + wg2[j] * vg + nb * (wg1[j] * g1 + wg0[j] * g2);
                        const float sg = hg * __builtin_amdgcn_rcpf(1.f + ex2(-hg * LOG2E));
                        r4[j] = sg * hu;
                    }
                    const int row = u.pm * 256 + ai * 128 + wr * 64 + m * 16 + fr;
                    u32x2 w; w.x = cvtpk(r4[0], r4[1]); w.y = cvtpk(r4[2], r4[3]);
                    if (!(ai == 0 && m == 0 && wr == 0 && fr < 2)) *(u32x2*)(act + (size_t)row * FF + ch0 + 4 * n) = w;
                    asm volatile("" ::: "memory");
                }
            }
        }
    }
};
constexpr int A_ROWB = 144, A_KBUF = 64 * A_ROWB, A_OFF_K = 0, A_OFF_V = 2 * A_KBUF, A_OFF_FLAG = 5 * A_KBUF;

__device__ __forceinline__ float lane_partner(float v, int hi) {
    auto rr = __builtin_amdgcn_permlane32_swap(__float_as_uint(v), __float_as_uint(v), false, false);
    return __uint_as_float(hi ? rr[0] : rr[1]);
}

template <int MODE>
__device__ __forceinline__ void attn_unit(int b, int h, int qb, const bf16* Q, const bf16* __restrict__ K, const bf16* __restrict__ VT, const float* __restrict__ C2, bf16* O, LAS unsigned char* lds) {
    int tid_ = threadIdx.x; asm volatile("" : "+v"(tid_));
    const int tid = tid_, lane = tid & 63, r32 = lane & 31, hi = lane >> 5; const int wid = __builtin_amdgcn_readfirstlane(tid >> 6);
    const size_t rowbase = (size_t)b * SEQ; const int q0 = qb * 256; const int NT = (q0 + 256) / 64;
    const int qabs = q0 + wid * 32 + r32;
    const bf16* Qw = Q + (rowbase + qabs) * D + h * 64;
    bf16x8 qr[4];
#pragma unroll
    for (int d0 = 0; d0 < 4; ++d0) qr[d0] = *(const bf16x8*)(Qw + d0 * 16 + hi * 8);
    const int lrow = tid >> 3, lch = tid & 7;
    const bf16* ksrc = K + (rowbase + lrow) * D + h * 64 + lch * 8;
    const bf16* vsrc = VT + (size_t)(h * 64 + lrow) * M + rowbase + lch * 8;
    const float* csrc = C2 + ((size_t)(b * NH + h)) * SEQ + lrow;
    const int ldst = lrow * A_ROWB + lch * 16;
    const int krow = (r32 & ~12) | ((r32 & 4) << 1) | ((r32 & 8) >> 1);
    const int koff = krow * A_ROWB + hi * 16, voff = r32 * A_ROWB + hi * 16;
    u32x4 kregs[2], vregs[2]; float cregs[2] = {0.f, 0.f};
#define A_TILE(i) (NT - 1 - (i))
#define A_LOAD(t, S) do { kregs[S] = *(const u32x4*)(ksrc + (size_t)(t) * 64 * D); vregs[S] = *(const u32x4*)(vsrc + (t) * 64); if (MODE == 0) cregs[S] = csrc[(t) * 64]; } while (0)
#define A_WRITE(buf, vbuf_, S) do { *(LAS u32x4*)(lds + A_OFF_K + (buf) * A_KBUF + ldst) = kregs[S]; *(LAS u32x4*)(lds + A_OFF_V + (vbuf_) * A_KBUF + ldst) = vregs[S]; \
        if (MODE == 0 && lch == 0) { const float nb_ = -cregs[S]; const unsigned hb_ = cvtpk(nb_, 0.f) & 0xffffu; const float rem_ = nb_ - __uint_as_float(hb_ << 16); \
            *(LAS u32x4*)(lds + A_OFF_K + (buf) * A_KBUF + lrow * A_ROWB + 128) = (u32x4){hb_ | (cvtpk(rem_, 0.f) << 16), 0u, 0u, 0u}; } } while (0)
    f32x16 o0, o1;
#pragma unroll
    for (int r = 0; r < 16; ++r) { o0[r] = 0.f; o1[r] = 0.f; }
    float mrun = -INFINITY, lrun = 0.f, carry = 1.f;
    f32x16 negm; bool started = false;
#pragma unroll
    for (int r = 0; r < 16; ++r) negm[r] = 0.f;
    const bf16x8 qone = hi ? (bf16x8){0, 0, 0, 0, 0, 0, 0, 0} : (bf16x8){0x3f80, 0x3f80, 0, 0, 0, 0, 0, 0};
    if (MODE == 0 && tid == 0) *(LAS u32x4*)(lds + A_OFF_FLAG + 64) = (u32x4){0u, 0u, 0u, 0u};
    A_LOAD(A_TILE(0), 0); A_WRITE(0, 0, 0);
    A_LOAD(A_TILE(1), 1);
    asm volatile("" : "+v"(qr[0]), "+v"(qr[1]), "+v"(qr[2]), "+v"(qr[3]));
    __syncthreads();
    const bool lag = (MODE == 0) || wid >= 4; bool pend = false; bf16x8 P[4];
#pragma unroll
    for (int ii = 0; ii < 4; ++ii) P[ii] = (bf16x8){0, 0, 0, 0, 0, 0, 0, 0};
    int vbuf = 0, vprev = 0;
#define A_PV(vslot) do { const LAS unsigned char* vb_ = lds + A_OFF_V + (vslot) * A_KBUF; bf16x8 vf0_[4], vf1_[4]; \
        _Pragma("unroll") for (int ii = 0; ii < 4; ++ii) { vf0_[ii] = *(const LAS bf16x8*)(vb_ + voff + ii * 32); vf1_[ii] = *(const LAS bf16x8*)(vb_ + 32 * A_ROWB + voff + ii * 32); } \
        __builtin_amdgcn_sched_barrier(0);     \
        __builtin_amdgcn_s_setprio(1); \
        _Pragma("unroll") for (int ii = 0; ii < 4; ++ii) { o0 = __builtin_amdgcn_mfma_f32_32x32x16_bf16(vf0_[ii], P[ii], o0, 0, 0, 0); o1 = __builtin_amdgcn_mfma_f32_32x32x16_bf16(vf1_[ii], P[ii], o1, 0, 0, 0); } \
        __builtin_amdgcn_s_setprio(0); } while (0)
    bool stop = false, wdone = false;
    for (int ip = 0; ip < NT / 2 && !stop; ++ip) {
#pragma unroll
    for (int sub = 0; sub < 2; ++sub) {
        const int i = 2 * ip + sub;
        const int buf = sub, t = A_TILE(i);
        { const int t2_ = A_TILE(i + 2); A_LOAD(t2_ < 0 ? 0 : t2_, sub); }
        const LAS unsigned char* kb = lds + A_OFF_K + buf * A_KBUF;
        if (MODE == 1 && lag && pend) { A_PV(vprev); pend = false; }
        if (64 * t <= q0 + wid * 32 + 31 && !(MODE == 1 && wdone)) {
        f32x16 s0, s1;
        {
            bf16x8 kf0_[5], kf1_[5];
#pragma unroll
            for (int d0 = 0; d0 < 4; ++d0) { kf0_[d0] = *(const LAS bf16x8*)(kb + koff + d0 * 32); kf1_[d0] = *(const LAS bf16x8*)(kb + 32 * A_ROWB + koff + d0 * 32); }
            if (MODE == 0) {
                const LAS unsigned char* zp = lds + A_OFF_FLAG + 64;
                const LAS unsigned char* p0 = hi ? zp : kb + krow * A_ROWB + 128; const LAS unsigned char* p1 = hi ? zp : kb + (krow + 32) * A_ROWB + 128;
                kf0_[4] = *(const LAS bf16x8*)p0; kf1_[4] = *(const LAS bf16x8*)p1;
            }
            __builtin_amdgcn_sched_barrier(0);
            __builtin_amdgcn_s_setprio(1);
            s0 = __builtin_amdgcn_mfma_f32_32x32x16_bf16(kf0_[0], qr[0], negm, 0, 0, 0);
            s1 = __builtin_amdgcn_mfma_f32_32x32x16_bf16(kf1_[0], qr[0], negm, 0, 0, 0);
#pragma unroll
            for (int d0 = 1; d0 < 4; ++d0) {
                s0 = __builtin_amdgcn_mfma_f32_32x32x16_bf16(kf0_[d0], qr[d0], s0, 0, 0, 0);
                s1 = __builtin_amdgcn_mfma_f32_32x32x16_bf16(kf1_[d0], qr[d0], s1, 0, 0, 0);
            }
            if (MODE == 0) {
                s0 = __builtin_amdgcn_mfma_f32_32x32x16_bf16(kf0_[4], qone, s0, 0, 0, 0);
                s1 = __builtin_amdgcn_mfma_f32_32x32x16_bf16(kf1_[4], qone, s1, 0, 0, 0);
            }
            __builtin_amdgcn_s_setprio(0);
        }
        const bool band = t >= NT - 4;
        const int kbase = t * 64 + 8 * hi;
        if (MODE == 0) {
            if (band) {
#pragma unroll
                for (int r = 0; r < 16; ++r) { const int key = kbase + (r & 7) + 16 * (r >> 3); if (key > qabs) s0[r] = -INFINITY; if (key + 32 > qabs) s1[r] = -INFINITY; }
            }
            float mx = __builtin_fmaxf(s0[0], s1[0]);
#pragma unroll
            for (int r = 1; r < 16; ++r) mx = __builtin_fmaxf(__builtin_fmaxf(mx, s0[r]), s1[r]);
            mx = fmaxf(mx, lane_partner(mx, hi));
            if (!started) {
                started = true; mrun = mx;
#pragma unroll
                for (int r = 0; r < 16; ++r) { s0[r] -= mx; s1[r] -= mx; negm[r] = -mx; }
            } else if (__any(mx > 0.f)) {
                if (pend) { A_PV(vprev); pend = false;
#pragma unroll
                    for (int ii = 0; ii < 4; ++ii) P[ii] = (bf16x8){0, 0, 0, 0, 0, 0, 0, 0}; }
                const float dl = fmaxf(mx, 0.f), alpha = ex2(-dl);
                lrun *= alpha; mrun += dl;
#pragma unroll
                for (int r = 0; r < 16; ++r) { o0[r] *= alpha; o1[r] *= alpha; s0[r] -= dl; s1[r] -= dl; negm[r] -= dl; }
            }
            {
                const LAS unsigned char* vb_ = lds + A_OFF_V + (pend ? vprev : vbuf) * A_KBUF;
                bf16x8 vf0_[4], vf1_[4];
#pragma unroll
                for (int ii = 0; ii < 4; ++ii) { vf0_[ii] = *(const LAS bf16x8*)(vb_ + voff + ii * 32); vf1_[ii] = *(const LAS bf16x8*)(vb_ + 32 * A_ROWB + voff + ii * 32); }
                float ls = 0.f; bf16x8 Pn[4];
#pragma unroll
                for (int ii = 0; ii < 4; ++ii) {
                    o0 = __builtin_amdgcn_mfma_f32_32x32x16_bf16(vf0_[ii], P[ii], o0, 0, 0, 0); o1 = __builtin_amdgcn_mfma_f32_32x32x16_bf16(vf1_[ii], P[ii], o1, 0, 0, 0);
                    float pv_[8];
#pragma unroll
                    for (int e = 0; e < 8; ++e) { pv_[e] = ex2(ii < 2 ? s0[8 * (ii & 1) + e] : s1[8 * (ii & 1) + e]); ls += pv_[e]; }
                    u32x4 w; w.x = cvtpk(pv_[0], pv_[1]); w.y = cvtpk(pv_[2], pv_[3]); w.z = cvtpk(pv_[4], pv_[5]); w.w = cvtpk(pv_[6], pv_[7]);
                    Pn[ii] = __builtin_bit_cast(bf16x8, w);
                    __builtin_amdgcn_sched_barrier(0);
                }
                lrun += ls; pend = true;
#pragma unroll
                for (int ii = 0; ii < 4; ++ii) P[ii] = Pn[ii];
            }
        } else {
            f32x16 b0, b1;
#pragma unroll
            for (int r = 0; r < 16; ++r) {
                { const float rr = __builtin_amdgcn_rcpf(1.f + ex2(-s0[r])); b0[r] = 1.f - rr; s0[r] = rr; }
                { const float rr = __builtin_amdgcn_rcpf(1.f + ex2(-s1[r])); b1[r] = 1.f - rr; s1[r] = rr; }
            }
            if (band) {
#pragma unroll
                for (int r = 0; r < 16; ++r) { const int key = kbase + (r & 7) + 16 * (r >> 3);
                    if (key >= qabs) { b0[r] = 1.f; s0[r] = 0.f; } if (key + 32 >= qabs) { b1[r] = 1.f; s1[r] = 0.f; } }
            }
            float T[4];
#pragma unroll
            for (int a = 0; a < 4; ++a) { float tt = 1.f;
#pragma unroll
                for (int e = 0; e < 8; ++e) tt *= (a < 2 ? b0[8 * (a & 1) + e] : b1[8 * (a & 1) + e]);
                T[a] = tt; }
            float U[4], tot[4];
#pragma unroll
            for (int a = 0; a < 4; ++a) { U[a] = lane_partner(T[a], hi); tot[a] = T[a] * U[a]; }
            float later = carry;
#pragma unroll
            for (int a = 3; a >= 0; --a) {
                float run = later * (hi == 0 ? U[a] : 1.f);
#pragma unroll
                for (int e = 7; e >= 0; --e) {
                    if (a < 2) { const float lb = b0[8 * (a & 1) + e]; s0[8 * (a & 1) + e] *= run; run *= lb; }
                    else       { const float lb = b1[8 * (a & 1) + e]; s1[8 * (a & 1) + e] *= run; run *= lb; }
                }
                later *= tot[a];
            }
            carry = later;
        }
        if (MODE == 1) {
#pragma unroll
        for (int ii = 0; ii < 4; ++ii) { u32x4 w;
            if (ii < 2) { w.x = cvtpk(s0[8 * ii], s0[8 * ii + 1]); w.y = cvtpk(s0[8 * ii + 2], s0[8 * ii + 3]); w.z = cvtpk(s0[8 * ii + 4], s0[8 * ii + 5]); w.w = cvtpk(s0[8 * ii + 6], s0[8 * ii + 7]); }
            else { const int i2 = ii - 2; w.x = cvtpk(s1[8 * i2], s1[8 * i2 + 1]); w.y = cvtpk(s1[8 * i2 + 2], s1[8 * i2 + 3]); w.z = cvtpk(s1[8 * i2 + 4], s1[8 * i2 + 5]); w.w = cvtpk(s1[8 * i2 + 6], s1[8 * i2 + 7]); }
            P[ii] = __builtin_bit_cast(bf16x8, w); }
        if (lag) pend = true; else A_PV(vbuf);
        }
        }
        vprev = vbuf; vbuf = (vbuf == 2) ? 0 : vbuf + 1;
        if (i + 1 < NT) A_WRITE(buf ^ 1, vbuf, sub ^ 1);
        if (MODE == 1) {
            const bool done_w = __all(carry == 0.f); wdone = done_w;
            if (lane == 0) *(LAS unsigned*)(lds + A_OFF_FLAG + (i & 1) * 32 + wid * 4) = done_w ? 1u : 0u;
        }
        __syncthreads();
        if (MODE == 1) {
            const u32x4 f0 = *(const LAS u32x4*)(lds + A_OFF_FLAG + (i & 1) * 32), f1 = *(const LAS u32x4*)(lds + A_OFF_FLAG + (i & 1) * 32 + 16);
            if ((f0.x & f0.y & f0.z & f0.w & f1.x & f1.y & f1.z & f1.w) != 0u) { stop = true; break; }
        }
    }
    }
    if (lag && pend) A_PV(vprev);
    __syncthreads();
    float inv = 1.f;
    if (MODE == 0) { const float lt = lrun + lane_partner(lrun, hi); inv = 1.f / lt; }
    unsigned char* Ob = (unsigned char*)(O + (rowbase + qabs) * D + h * 64) + (hi ? 16 : 0);
    u32x2 wk[8];
#pragma unroll
    for (int k = 0; k < 8; ++k) {
        if (k < 4) { wk[k].x = cvtpk(o0[4 * k] * inv, o0[4 * k + 1] * inv); wk[k].y = cvtpk(o0[4 * k + 2] * inv, o0[4 * k + 3] * inv); }
        else { wk[k].x = cvtpk(o1[4 * (k - 4)] * inv, o1[4 * (k - 4) + 1] * inv); wk[k].y = cvtpk(o1[4 * (k - 4) + 2] * inv, o1[4 * (k - 4) + 3] * inv); }
    }
#pragma unroll
    for (int k = 0; k < 8; k += 2) {
        auto rx = __builtin_amdgcn_permlane32_swap(wk[k].x, wk[k + 1].x, false, false);
        auto ry = __builtin_amdgcn_permlane32_swap(wk[k].y, wk[k + 1].y, false, false);
        *(u32x4*)(Ob + 16 * k) = (u32x4){rx[0], ry[0], rx[1], ry[1]};
    }
#undef A_TILE
#undef A_LOAD
#undef A_WRITE
#undef A_PV
}

template <int MODE>
__device__ __forceinline__ void attn_phase(int vcu, int G, const bf16* Q, const bf16* K, const bf16* VT, const float* C2, bf16* O, LAS unsigned char* lds) {
    for (int v = vcu; v < 256; v += G) {
        const int bh = v >> 1, s = v & 1;
        for (int i = 0; i < 8; ++i) { const int jj = 2 * (i >> 1) + s; const int qb = (i & 1) ? 15 - jj : jj;
            attn_unit<MODE>(bh / NH, bh % NH, qb, Q, K, VT, C2, O, lds); }
    }
}
#define atomicAdd_u(p, v) atomicAdd(p, v)
#define XB_TMO      128
#define XB_XCNT(j)  (256  + 64 * (j))
#define XB_XSUB(j)  (1280 + 64 * (j))
#define XB_XGEN(j)  (2304 + 64 * (j))
#define XB_TOP      3328
#define XB_TOPGEN   3392
#define XCD_BAR_WORDS 3456
#define XB_SPIN_CAP (1u << 18)

__device__ __forceinline__ unsigned xb_ld(unsigned* p)              { return __hip_atomic_load(p, __ATOMIC_RELAXED, __HIP_MEMORY_SCOPE_AGENT); }
__device__ __forceinline__ unsigned xb_add(unsigned* p, unsigned v) { return __hip_atomic_fetch_add(p, v, __ATOMIC_RELAXED, __HIP_MEMORY_SCOPE_AGENT); }
__device__ __forceinline__ unsigned xb_xcc_id() { return (unsigned)__builtin_amdgcn_s_getreg((3 << 11) | 20) & 0xFu; }
#define XB_SPIN(cond, bar) do { unsigned _sp = 0; while (cond) { __builtin_amdgcn_s_sleep(1); \
    if ((++_sp & 255u) == 0u) { if (xb_ld(&(bar)[XB_TMO])) break; if (_sp > XB_SPIN_CAP) { atomicAdd(&(bar)[XB_TMO], 1u); break; } } } } while (0)

struct XcdBarrier {
    unsigned* bar; unsigned x;
    volatile LAS unsigned* st;
};

__device__ __forceinline__ XcdBarrier xcd_barrier_post(unsigned* bar, volatile LAS unsigned* st) {
    XcdBarrier b; b.bar = bar; b.x = xb_xcc_id(); b.st = st;
    if (threadIdx.x == 0) (void)xb_add(&bar[XB_XCNT(b.x)], 1u);
    return b;
}
__device__ __forceinline__ void xcd_barrier_complete(unsigned* bar, unsigned x, unsigned& nloc, unsigned& nx) {
    const unsigned G = gridDim.x * gridDim.y * gridDim.z;
    unsigned sum, cnt, mine, sp = 0u;
    for (;;) {
        sum = 0u; cnt = 0u; mine = 0u;
#pragma unroll
        for (unsigned j = 0; j < 16; ++j) { const unsigned c = xb_ld(&bar[XB_XCNT(j)]); sum += c; cnt += (c > 0u) ? 1u : 0u; mine = (j == x) ? c : mine; }
        if (sum == G) break;
        __builtin_amdgcn_s_sleep(1);
        if ((++sp & 255u) == 0u) { if (xb_ld(&bar[XB_TMO])) break; if (sp > XB_SPIN_CAP) { atomicAdd(&bar[XB_TMO], 1u); break; } }
    }
    nloc = mine > 0u ? mine : 1u; nx = cnt > 0u ? cnt : 1u;
}

__device__ __forceinline__ void xcd_barrier(const XcdBarrier& b) {
    asm volatile("s_waitcnt vmcnt(0)" ::: "memory");
    __syncthreads();
    if (threadIdx.x == 0) {
        unsigned* bar = b.bar;
        __builtin_amdgcn_s_waitcnt(0);
        unsigned nloc = b.st[0], nx = b.st[1];
        if (nloc == 0u) { xcd_barrier_complete(bar, b.x, nloc, nx); b.st[0] = nloc; b.st[1] = nx; }
        const unsigned old = xb_add(&bar[XB_XSUB(b.x)], 1u);
        const unsigned gen = old / nloc;
        if (old + 1u == (gen + 1u) * nloc) {
            __builtin_amdgcn_fence(__ATOMIC_RELEASE, "agent");
            asm volatile("s_waitcnt vmcnt(0)" ::: "memory");
            const unsigned og = xb_add(&bar[XB_TOP], 1u);
            const unsigned tg = og / nx;
            if (og + 1u == (tg + 1u) * nx) xb_add(&bar[XB_TOPGEN], 1u);
            else XB_SPIN(xb_ld(&bar[XB_TOPGEN]) == tg, bar);
            __builtin_amdgcn_fence(__ATOMIC_ACQUIRE, "agent");
            xb_add(&bar[XB_XGEN(b.x)], 1u);
            asm volatile("s_waitcnt vmcnt(0)" ::: "memory");
        } else {
            XB_SPIN(xb_ld(&bar[XB_XGEN(b.x)]) == gen, bar);
            __builtin_amdgcn_fence(__ATOMIC_ACQUIRE, "agent");
            asm volatile("s_waitcnt vmcnt(0)" ::: "memory");
        }
    }
    __syncthreads();
}

struct Args { const float* in[13]; float* out; unsigned char* ws; };

__device__ __forceinline__ void transpose_item(const float* W, int ldw, int k0, int n0, bf16* WT, int K, int drow0, LAS float* scr, int lane) {
#pragma unroll 8
    for (int i = 0; i < 32; ++i) { const int kk = 2 * i + (lane >> 5); scr[kk * 33 + (lane & 31)] = W[(size_t)(k0 + kk) * ldw + n0 + (lane & 31)]; }
    asm volatile("s_waitcnt lgkmcnt(0)" ::: "memory");
    const int c = lane & 7;
#pragma unroll
    for (int j = 0; j < 4; ++j) { const int n = (lane >> 3) + 8 * j; const LAS float* s = scr + (8 * c) * 33 + n;
        u32x4 o; o.x = cvtpk(s[0], s[33]); o.y = cvtpk(s[2 * 33], s[3 * 33]); o.z = cvtpk(s[4 * 33], s[5 * 33]); o.w = cvtpk(s[6 * 33], s[7 * 33]);
        *(u32x4*)(WT + (size_t)(drow0 + n) * K + k0 + 8 * c) = o; }
    asm volatile("s_waitcnt lgkmcnt(0)" ::: "memory");
}

#define PIN(T, i) ((T*)ldptr(lds, (i)))
__device__ __forceinline__ void* ldptr(LAS unsigned char* lds, int i) {
    const u32x2 v = *(const LAS u32x2*)(lds + PTAB_OFF + 8 * i);
    const unsigned long long p = ((unsigned long long)(unsigned)__builtin_amdgcn_readfirstlane((int)v.y) << 32) | (unsigned)__builtin_amdgcn_readfirstlane((int)v.x);
    return (void*)(__attribute__((address_space(1))) char*)p; }
__device__ __forceinline__ void prologue(LAS unsigned char* lds, int gw, int NGW, int wave, int lane) {
    unsigned char* a_ws = PIN(unsigned char, 14);
    LAS float* scr = (LAS float*)(lds + wave * 16384);
    constexpr int I_QKV = 16 * 96, I_O = 16 * 32, I_UP = 16 * 176, I_DN = 44 * 32, I_L = I_QKV + I_O + I_UP + I_DN;
    for (int it = gw; it < DEPTH * I_L; it += NGW) {
        const int l = it / I_L; int r = it % I_L; const int j = l >> 1; const bool fox = !(l & 1);
        bf16* wl = (bf16*)(a_ws + WS_W + (size_t)l * W_LAYER);
        if (r < I_QKV) { const int kb = r / 96, n0 = 32 * (r % 96);
            const float* W = fox ? PIN(const float, 4) + (size_t)j * D * 3088 : PIN(const float, 7) + (size_t)j * D * 3072; const int ldw = fox ? 3088 : 3072;
            if (n0 < 2048) transpose_item(W, ldw, 64 * kb, n0, wl + WO_QK / 2, D, n0, scr, lane);
            else transpose_item(W, ldw, 64 * kb, n0, wl + WO_V / 2, D, n0 - 2048, scr, lane);
            continue; }
        r -= I_QKV;
        if (r < I_O) { const int kb = r / 32, n0 = 32 * (r % 32); const float* W = (fox ? PIN(const float, 6) : PIN(const float, 8)) + (size_t)j * D * D;
            transpose_item(W, D, 64 * kb, n0, wl + WO_O / 2, D, n0, scr, lane); continue; }
        r -= I_O;
        if (r < I_UP) { const int kb = r / 176, c = 32 * (r % 176); const int drow0 = c < FF ? 256 * (c / 128) + (c % 128) : 256 * ((c - FF) / 128) + 128 + ((c - FF) % 128);
            transpose_item(PIN(const float, 9) + (size_t)l * D * FF2, FF2, 64 * kb, c, wl + WO_UP / 2, D, drow0, scr, lane); continue; }
        r -= I_UP;
        { const int kb = r / 32, n0 = 32 * (r % 32); transpose_item(PIN(const float, 12) + (size_t)l * FF * D, D, 64 * kb, n0, wl + WO_DN / 2, FF, n0, scr, lane); }
    }
}

template <bool FOX, bool SRC_BF16>
__device__ __forceinline__ void norm_phase(const void* src, const float* gain, bf16* xn, const float* Wf, const float* bfp, float* flog, LAS unsigned char* lds, int vcu, int G) {
    int tid = threadIdx.x; asm volatile("" : "+v"(tid));
    const int lane = tid & 63, gw = vcu * NWAVES + (tid >> 6), NGW = G * NWAVES;
    LAS float* wf = (LAS float*)lds;
    if (FOX) {
        for (int k = tid; k < D; k += NTHR) { const f32x4* p = (const f32x4*)(Wf + (size_t)k * 3088 + 3072);
#pragma unroll
            for (int q = 0; q < 4; ++q) { const f32x4 w = p[q];
#pragma unroll
                for (int e = 0; e < 4; ++e) wf[(4 * q + e) * 1024 + k] = w[e]; } }
        __syncthreads();
    }
    f32x4 g[4];
#pragma unroll
    for (int j = 0; j < 4; ++j) g[j] = ((const f32x4*)gain)[lane + 64 * j];
    for (int m = gw; m < M; m += NGW) {
        f32x4 v[4]; float s = 0.f;
#pragma unroll
        for (int j = 0; j < 4; ++j) {
            if (SRC_BF16) { const u32x2 w = ((const u32x2*)((const bf16*)src + (size_t)m * D))[lane + 64 * j]; v[j] = (f32x4){bflo(w.x), bfhi(w.x), bflo(w.y), bfhi(w.y)}; }
            else v[j] = ((const f32x4*)((const float*)src + (size_t)m * D))[lane + 64 * j];
            s += (v[j].x * v[j].x + v[j].y * v[j].y) + (v[j].z * v[j].z + v[j].w * v[j].w); }
        const float rstd = 1.0f / sqrtf(wave_sum(s) * (1.f / D) + NORM_EPS);
        u32x2* o8 = (u32x2*)(xn + (size_t)m * D) + lane;
#pragma unroll
        for (int j = 0; j < 4; ++j) { v[j] = v[j] * rstd * g[j]; u32x2 w; w.x = cvtpk(v[j].x, v[j].y); w.y = cvtpk(v[j].z, v[j].w); o8[64 * j] = w; }
        if (FOX) {
            float mine = 0.f; int lane_l = lane; asm volatile("" : "+v"(lane_l));
#pragma unroll
            for (int hh = 0; hh < 16; ++hh) { float acc = 0.f;
#pragma unroll
                for (int j = 0; j < 4; ++j) { const f32x4 w = *(const LAS f32x4*)(wf + hh * 1024 + 256 * j + 4 * lane); acc += (v[j].x * w.x + v[j].y * w.y) + (v[j].z * w.z + v[j].w * w.w); }
                acc = wave_sum(acc); mine = (lane_l == hh) ? acc : mine; }
            if (lane < 16) { const float x2 = (mine + bfp[lane]) * LOG2E; flog[(size_t)m * 16 + lane] = fminf(x2, 0.f) - lg2(1.f + ex2(-fabsf(x2))); }
        }
    }
    if (FOX) __syncthreads();
}

__device__ __forceinline__ void scan_phase(const float* flog, float* c2, LAS unsigned char* lds, int G) {
    int tid = threadIdx.x; asm volatile("" : "+v"(tid));
    const int lane = tid & 63, wave = tid >> 6;
    LAS float* wsum = (LAS float*)(lds + MISC_OFF);
    for (int bh = blockIdx.x; bh < BATCH * NH; bh += G) {
        const int b = bh / NH, h = bh % NH;
        float v[8]; float run = 0.f;
#pragma unroll
        for (int i = 0; i < 8; ++i) { run += flog[((size_t)b * SEQ + 8 * tid + i) * 16 + h]; v[i] = run; }
        float incl = run;
#pragma unroll
        for (int o = 1; o < 64; o <<= 1) { const float nb = __shfl_up(incl, o); if (lane >= o) incl += nb; }
        if (lane == 63) wsum[wave] = incl;
        __syncthreads();
        float woff = 0.f;
#pragma unroll
        for (int w = 0; w < NWAVES; ++w) woff += (w < wave) ? wsum[w] : 0.f;
        const float excl = incl - run + woff;
        f32x4 o0 = (f32x4){v[0] + excl, v[1] + excl, v[2] + excl, v[3] + excl}, o1 = (f32x4){v[4] + excl, v[5] + excl, v[6] + excl, v[7] + excl};
        f32x4* dst = (f32x4*)(c2 + (size_t)bh * SEQ + 8 * tid); dst[0] = o0; dst[1] = o1;
        __syncthreads();
    }
}

__device__ __forceinline__ void fixup_phase(const float* edge, const float* raw01, const float* wconv, const float* bconv, bf16* act, int bx, int G) {
    int tid = threadIdx.x; asm volatile("" : "+v"(tid));
    const int gtid = bx * NTHR + tid, NGT = G * NTHR;
    for (int idx = gtid; idx < (M / 256) * 2 * FF; idx += NGT) {
        const int c = idx % FF, rr = (idx / FF) & 1, pm = idx / (2 * FF);
        const bool has = (pm % (SEQ / 256)) != 0;
        float r[2];
#pragma unroll
        for (int s = 0; s < 2; ++s) { const int col = s * FF + c;
            const float h0 = raw01[((size_t)pm * 2 + rr) * FF2 + col];
            const float e1 = has ? edge[((size_t)(pm - 1) * 2 + 1) * FF2 + col] : 0.f, e0 = has ? edge[((size_t)(pm - 1) * 2 + 0) * FF2 + col] : 0.f;
            const float hm1 = rr == 0 ? e1 : raw01[((size_t)pm * 2 + 0) * FF2 + col], hm2 = rr == 0 ? e0 : e1;
            r[s] = bconv[col] + wconv[2 * FF2 + col] * h0 + wconv[FF2 + col] * hm1 + wconv[col] * hm2; }
        const float sg = r[1] * __builtin_amdgcn_rcpf(1.f + ex2(-r[1] * LOG2E));
        act[(size_t)(pm * 256 + rr) * FF + c] = (bf16)(cvtpk(sg * r[0], 0.f) & 0xffffu);
    }
}


#ifndef DBG_STAGE
#define DBG_STAGE 0
#endif
#ifndef DBG_SKIP
#define DBG_SKIP 0
#endif
#ifndef DBG_FRAC
#define DBG_FRAC 1
#endif
__device__ __forceinline__ void dbg_dump_bf16(const bf16* src, float* out, int bx, int G) {
    int tid = threadIdx.x; asm volatile("" : "+v"(tid));
    for (size_t i = (size_t)bx * NTHR + tid; i < (size_t)M * D; i += (size_t)G * NTHR) { float v = __uint_as_float((unsigned)src[i] << 16); if (!(fabsf(v) < 1e30f)) v = 10000.f; out[i] = v; }
}

__device__ __forceinline__ float bf2f(bf16 v) { return __uint_as_float((unsigned)v << 16); }
__device__ __forceinline__ unsigned hash32(unsigned x) { x ^= x >> 16; x *= 0x7feb352du; x ^= x >> 15; x *= 0x846ca68bu; x ^= x >> 16; return x; }
__device__ __forceinline__ void dbg_acc(float* word, float got, float exp_) { const float d = fabsf(got - exp_) / (fabsf(exp_) + 0.05f); atomicMax((unsigned*)word, __float_as_uint(d)); }
__device__ __forceinline__ void dbg_check_qkv(const bf16* xn, const float* W  , const bf16* q, const bf16* k, const bf16* vt, float* word, int bx, int G) {
    int tid = threadIdx.x; asm volatile("" : "+v"(tid));
    const unsigned sidx = bx * NTHR + tid; if (sidx >= 16384u) return;
    const unsigned hsh = hash32(sidx * 2654435761u + 12345u); const int row = hsh % M, col = (hsh >> 15) % 3072;
    float acc = 0.f; for (int kk = 0; kk < D; ++kk) acc += bf2f(xn[(size_t)row * D + kk]) * W[(size_t)kk * 3088 + col];
    float got; if (col < 1024) { got = bf2f(q[(size_t)row * D + col]); acc *= QSCALE; } else if (col < 2048) got = bf2f(k[(size_t)row * D + col - 1024]); else got = bf2f(vt[(size_t)(col - 2048) * M + row]);
    dbg_acc(word, got, acc);
}
__device__ __forceinline__ void dbg_check_act(const bf16* xn, const float* Wup  , const float* wconv, const float* bconv, const bf16* act, float* word, int bx, int G, int mode) {
    int tid = threadIdx.x; asm volatile("" : "+v"(tid));
    const unsigned sidx = bx * NTHR + tid; if (sidx >= 16384u) return;
    const unsigned hsh = hash32(sidx * 2654435761u + 777u); int row = hsh % M; int c = (hsh >> 15) % FF;
    if (mode == 7) { row = (row & ~15) + 2 + (int)((hsh >> 27) % 12u); c = (c & ~127) + (int)((hsh >> 20) % 32u); }
    if (mode == 9) { row = (row & ~255 & ~(8 * 256)) + 2 + (int)((hsh >> 27) % 12u) + 16 * (int)((hsh >> 23) % 16u); c = c % 512; }
    if (mode == 8) { row = (row & ~255) + 2 + (int)((hsh >> 27) % 12u); }
    if (mode == 1) row = (row & ~255) + (sidx & 1);
    if (mode == 2) row = (row & ~63) + (sidx & 1);
    if (mode == 3) row = (row & ~15) + (sidx & 1);
    if (mode == 4) row = (row & ~15) + 2 + (int)((hsh >> 27) % 14u);
    if (mode == 5) row = (row & ~15) + 14 + (sidx & 1);
    if (mode == 6) row = (row & ~15) + 2 + (int)((hsh >> 27) % 12u);
    float hc[2];
    for (int s2 = 0; s2 < 2; ++s2) { const int col = s2 * FF + c; float tot = bconv[col];
        for (int tap = 0; tap < 3; ++tap) { const int r = row - 2 + tap; if ((r >> 12) != (row >> 12) || r < 0) continue;
            float acc = 0.f; for (int kk = 0; kk < D; ++kk) acc += bf2f(xn[(size_t)r * D + kk]) * Wup[(size_t)kk * FF2 + col];
            tot += wconv[tap * FF2 + col] * acc; }
        hc[s2] = tot; }
    const float exp_ = hc[0] * hc[1] / (1.f + __expf(-hc[1]));
    const float got_ = bf2f(act[(size_t)row * FF + c]);
    if (DBG_FRAC) { if (fabsf(got_ - exp_) > 0.1f * (fabsf(exp_) + 0.2f)) atomicAdd(word, 1.f / 16384.f); }
    else dbg_acc(word, got_, exp_);
}
__device__ __forceinline__ void dbg_check_attn(const bf16* q, const bf16* k, const bf16* vt, const float* c2, const bf16* o, float* word, int bx, int G, int mode) {
    int tid = threadIdx.x; asm volatile("" : "+v"(tid));
    const int lane = tid & 63; const unsigned sidx = bx * NWAVES + (tid >> 6); if (sidx >= 1024u) return;
    const unsigned hsh = hash32(sidx * 2654435761u + 99u); const int b = hsh % BATCH, h = (hsh >> 8) % NH; int qp = (hsh >> 14) % SEQ; if ((sidx & 7) == 0) qp = (qp & ~255) + (sidx >> 3) % 70;
    const size_t rb = (size_t)b * SEQ; const float qv = bf2f(q[(rb + qp) * D + h * 64 + lane]);
    float od = 0.f;
    if (mode == 0) {
        float mx = -INFINITY; for (int j = 0; j <= qp; ++j) { const float z = wave_sum(qv * bf2f(k[(rb + j) * D + h * 64 + lane])) - c2[((size_t)(b * NH + h)) * SEQ + j]; mx = fmaxf(mx, z); }
        float l = 0.f; for (int j = 0; j <= qp; ++j) { const float z = wave_sum(qv * bf2f(k[(rb + j) * D + h * 64 + lane])) - c2[((size_t)(b * NH + h)) * SEQ + j]; const float p = exp2f(z - mx); l += p; od += p * bf2f(vt[(size_t)(h * 64 + lane) * M + rb + j]); }
        od /= l;
    } else {
        float tail = 0.f; for (int j = qp - 1; j >= 0 && tail > -200.f; --j) { const float z = wave_sum(qv * bf2f(k[(rb + j) * D + h * 64 + lane]));
            const float sp = log2f(1.f + exp2f(z)); const float a = exp2f(z - sp + tail); tail -= sp; od += a * bf2f(vt[(size_t)(h * 64 + lane) * M + rb + j]); }
    }
    const float got = bf2f(o[(rb + qp) * D + h * 64 + lane]);
    const float d = fabsf(got - od) / (fabsf(od) + 0.02f); atomicMax((unsigned*)word, __float_as_uint(d));
}
__device__ __forceinline__ void dbg_check_resid(const float* base, const bf16* a, int K, const float* W, const float* hs, float* word, int bx, int G) {
    int tid = threadIdx.x; asm volatile("" : "+v"(tid));
    const unsigned sidx = bx * NTHR + tid; if (sidx >= 16384u) return;
    const unsigned hsh = hash32(sidx * 2654435761u + 4242u); const int row = hsh % M, col = (hsh >> 15) % D;
    float acc = 0.f; for (int kk = 0; kk < K; ++kk) acc += bf2f(a[(size_t)row * K + kk]) * W[(size_t)kk * D + col];
    const float exp_ = base[(size_t)row * D + col] + acc; dbg_acc(word, hs[(size_t)row * D + col], exp_);
}
#define DBG_BEGIN() do { if (bx0 == 0 && threadIdx.x == 0) *(float*)(PIN(unsigned char, 14) + WS_FLOG - 256) = 0.f; } while (0)
#define DBG_WORD ((float*)(PIN(unsigned char, 14) + WS_FLOG - 256))
#define DBG_FINISH() do { { int tz = threadIdx.x; asm volatile("" : "+v"(tz)); float* od_ = PIN(float, 13); for (size_t i = (size_t)bx0 * NTHR + tz; i < (size_t)M * D; i += (size_t)G0 * NTHR) od_[i] = 0.f; } GSYNC(); \
    if (bx0 == 0 && threadIdx.x == 0) PIN(float, 13)[0] = 10.f + 1000.f * *DBG_WORD; return; } while (0)

#ifndef DBG_DUP
#define DBG_DUP 0
#endif
#ifndef A_QG0
#define A_QG0 2
#endif
#ifndef DBG_TA
#define DBG_TA -1
#endif
#ifndef DBG_TB
#define DBG_TB -1
#endif
#define TSTAMP(cat) do { if (DBG_TA >= 0 && bx0 == 0 && threadIdx.x == 0) { const unsigned long long now_ = __builtin_amdgcn_s_memrealtime(); LAS unsigned* tw_ = (LAS unsigned*)(lds + TIME_OFF); \
    tw_[(cat)] += (unsigned)(now_ - (((unsigned long long)tw_[15] << 32) | tw_[14])); tw_[14] = (unsigned)now_; tw_[15] = (unsigned)(now_ >> 32); } } while (0)
#define GSYNC_CG() do { asm volatile("s_waitcnt vmcnt(0) lgkmcnt(0)" ::: "memory"); __builtin_amdgcn_fence(__ATOMIC_RELEASE, "agent"); grid.sync(); __builtin_amdgcn_fence(__ATOMIC_ACQUIRE, "agent"); } while (0)
#define GSYNC() do { xcd_barrier(xbar); if (DBG_DUP & 64) xcd_barrier(xbar); } while (0)
__global__ void __launch_bounds__(NTHR, 2) fwd_kernel(Args a) {
    extern __shared__ __attribute__((aligned(16))) unsigned char lds_raw[];
    LAS unsigned char* lds = (LAS unsigned char*)lds_raw;
    cg::grid_group grid = cg::this_grid();
    const int tid = threadIdx.x, lane = tid & 63; const int wave = __builtin_amdgcn_readfirstlane(tid >> 6);
    const int G0 = gridDim.x, bx0 = blockIdx.x;
    const int vcu0 = (G0 % 8 == 0) ? (bx0 % 8) * (G0 / 8) + bx0 / 8 : bx0;
    if (tid == 0) {
#pragma unroll
        for (int i = 0; i < 13; ++i) *(LAS unsigned long long*)(lds + PTAB_OFF + 8 * i) = (unsigned long long)a.in[i];
        *(LAS unsigned long long*)(lds + PTAB_OFF + 8 * 13) = (unsigned long long)a.out; *(LAS unsigned long long*)(lds + PTAB_OFF + 8 * 14) = (unsigned long long)a.ws;
    }
    if (tid < 2) ((LAS unsigned*)(lds + MISC_OFF + 64))[tid] = 0u;
    __syncthreads();
    const XcdBarrier xbar = xcd_barrier_post((unsigned*)(PIN(unsigned char, 14) + WS_BAR), (volatile LAS unsigned*)(lds + MISC_OFF + 64));
#define WSP(T, off) ((T*)(PIN(unsigned char, 14) + (off)))
#define XN WSP(bf16, WS_XN)
#define QO WSP(bf16, WS_QO)
#define KB WSP(bf16, WS_K)
#define VT WSP(bf16, WS_VT)
#define ACT WSP(bf16, WS_ACT)
#define FLOG WSP(float, WS_FLOG)
#define C2 WSP(float, WS_C2)
#define EDGE WSP(float, WS_EDGE)
#define RAW01 WSP(float, WS_RAW01)
#define HS PIN(float, 13)
#define HSB WSP(bf16, WS_HSB)
#define XIN PIN(const float, 0)
    if (DBG_STAGE >= 30) DBG_BEGIN();
    if (DBG_TA >= 0 && bx0 == 0 && threadIdx.x == 0) { LAS unsigned* tw_ = (LAS unsigned*)(lds + TIME_OFF); for (int i_ = 0; i_ < 14; ++i_) tw_[i_] = 0u; const unsigned long long now_ = __builtin_amdgcn_s_memrealtime(); tw_[14] = (unsigned)now_; tw_[15] = (unsigned)(now_ >> 32); }
    prologue(lds, vcu0 * NWAVES + wave, G0 * NWAVES, wave, lane);
    if (DBG_DUP & 32) prologue(lds, vcu0 * NWAVES + wave, G0 * NWAVES, wave, lane);
    __syncthreads();
    norm_phase<true, false>(XIN, PIN(const float, 1), XN, PIN(const float, 4), PIN(const float, 5), FLOG, lds, vcu0, G0);
    if (PIN(unsigned char, 14) == nullptr) grid.sync();
    GSYNC(); TSTAMP(0);
    if (DBG_STAGE == 1) { dbg_dump_bf16(XN, HS, bx0, G0); return; }
    for (int l = 0; l < DEPTH; ++l) {
        const bool fox = !(l & 1); const int j = l >> 1;
        int G = G0, bx = bx0, vcu = vcu0; asm volatile("" : "+s"(G), "+s"(bx), "+s"(vcu));
        #define WL ((const bf16*)(PIN(unsigned char, 14) + WS_W + (size_t)l * W_LAYER))
        if (l > 0) {
            if (fox) norm_phase<true, true>(HSB, PIN(const float, 1) + l * D, XN, PIN(const float, 4) + (size_t)j * D * 3088, PIN(const float, 5) + j * NH, FLOG, lds, vcu, G);
            else norm_phase<false, true>(HSB, PIN(const float, 1) + l * D, XN, nullptr, nullptr, nullptr, lds, vcu, G);
            if (DBG_DUP & 16) norm_phase<false, true>(HSB, PIN(const float, 1) + l * D, XN, nullptr, nullptr, nullptr, lds, vcu, G);
            GSYNC(); TSTAMP(1);
        }
        if (fox) scan_phase(FLOG, C2, lds, G);
        for (int rep_ = 0; rep_ < ((DBG_DUP & 1) ? 2 : 1); ++rep_) {
        { pg8::Gemm g{XN, WL + WO_QK / 2, M, 2048, D}; pg8::StaticOrder S; S.init(M, 2048, G, bx);
          pg8::EpiBf16<0> E{QO, D, nullptr, D, (size_t)(WS_K - WS_QO) / 2, QSCALE};
#ifndef NO_QK
          pg8::gemm_phase<pg8::EpiBf16<0>, pg8::StaticOrder, true, true>(lds, g, S, E);
#endif
        }
        { pg8::Gemm g{WL + WO_V / 2, XN, D, M, D}; pg8::StaticOrder S; S.init(D, M, G, bx);
          pg8::EpiBf16<0> E{VT, M, nullptr, 0, 0, 1.f};
#ifndef NO_VT
          pg8::gemm_phase<pg8::EpiBf16<0>, pg8::StaticOrder, true, true>(lds, g, S, E);
#endif
        }
        }
        GSYNC(); TSTAMP(2);
        if (DBG_STAGE == 31 && l == 0) { dbg_check_qkv(XN, PIN(const float, 4), QO, KB, VT, DBG_WORD, bx, G); DBG_FINISH(); }
        if (DBG_STAGE == 32 && l == 0) { attn_phase<0>(vcu, G, QO, KB, VT, C2, XN, lds); GSYNC(); dbg_check_attn(QO, KB, VT, C2, XN, DBG_WORD, bx, G, 0); DBG_FINISH(); }
        if (DBG_STAGE == 35 && l == 1) { attn_phase<1>(vcu, G, QO, KB, VT, C2, XN, lds); GSYNC(); dbg_check_attn(QO, KB, VT, C2, XN, DBG_WORD, bx, G, 1); DBG_FINISH(); }
        if (DBG_STAGE == 2) { dbg_dump_bf16(QO, HS, bx, G); return; }
        if (DBG_STAGE == 3) { dbg_dump_bf16(KB, HS, bx, G); return; }
        if (DBG_STAGE == 4) { dbg_dump_bf16(VT, HS, bx, G); return; }
        if ((DBG_DUP & 4) && fox) attn_phase<0>(vcu, G, QO, KB, VT, C2, XN, lds);
        if ((DBG_DUP & 8) && !fox) attn_phase<1>(vcu, G, QO, KB, VT, C2, XN, lds);
#ifndef NO_ATT0
        if (fox || DBG_STAGE == 10) attn_phase<0>(vcu, G, QO, KB, VT, C2, QO, lds);
#endif
#ifndef NO_ATT1
        if (!fox && DBG_STAGE != 10) attn_phase<1>(vcu, G, QO, KB, VT, C2, QO, lds);
#endif
        GSYNC(); TSTAMP(fox ? 3 : 4);
        if (DBG_STAGE == 5) { dbg_dump_bf16(QO, HS, bx, G); return; }
        if (DBG_STAGE == 9 && l == 1) { dbg_dump_bf16(QO, HS, bx, G); return; }
        if ((DBG_SKIP & (fox ? 1 : 2)) != 0) {
            if (l == 0) { int tq = threadIdx.x; asm volatile("" : "+v"(tq)); const float* xs = XIN; float* hd = HS;
                for (size_t i = (size_t)bx * NTHR + tq; i < (size_t)M * D / 4; i += (size_t)G * NTHR) ((f32x4*)hd)[i] = ((const f32x4*)xs)[i]; }
        } else
        { pg8::Gemm g{QO, WL + WO_O / 2, M, D, D}; pg8::StaticOrder S; S.init(M, D, G, bx);
#ifndef NO_O
          if (l == 0) { EpiResid<true> E{XIN, HSB}; pg8::gemm_phase<EpiResid<true>, pg8::StaticOrder, true, true>(lds, g, S, E); }
          else { EpiResid<false> E{HSB, HSB}; pg8::gemm_phase<EpiResid<false>, pg8::StaticOrder, true, true>(lds, g, S, E); }
#endif
        }
        GSYNC(); TSTAMP(5);
        if (DBG_STAGE == 33 && l == 0) { dbg_check_resid(XIN, QO, D, PIN(const float, 6), HS, DBG_WORD, bx, G); DBG_FINISH(); }
        if (DBG_STAGE == 6) return;
        if ((DBG_SKIP & 4) != 0) continue;
        if ((DBG_STAGE == 8 || DBG_STAGE == 10) && l == 1) return;
        norm_phase<false, true>(HSB, PIN(const float, 2) + l * D, XN, nullptr, nullptr, nullptr, lds, vcu, G);
        if (DBG_DUP & 16) norm_phase<false, true>(HSB, PIN(const float, 2) + l * D, XN, nullptr, nullptr, nullptr, lds, vcu, G);
        GSYNC(); TSTAMP(1);
        #define WCONV (PIN(const float, 10) + (size_t)l * 3 * FF2)
#define BCONV (PIN(const float, 11) + (size_t)l * FF2)
        for (int rep_ = 0; rep_ < ((DBG_DUP & 2) ? 2 : 1); ++rep_)
        { pg8::Gemm g{XN, WL + WO_UP / 2, M, FF2, D}; pg8::StaticOrder S; S.init(M, FF2, G, bx);
          EpiConvGate E{ACT, WCONV, BCONV, EDGE, RAW01, (LAS float*)(lds + XCH_OFF)};
#ifndef NO_UP
          pg8::gemm_phase<EpiConvGate, pg8::StaticOrder, true, true>(lds, g, S, E);
#endif
        }
        GSYNC(); TSTAMP(6);
        fixup_phase(EDGE, RAW01, WCONV, BCONV, ACT, bx, G);
        GSYNC(); TSTAMP(7);
        if (DBG_STAGE >= 40 && DBG_STAGE <= 49 && l == 0) { dbg_check_act(XN, PIN(const float, 9), WCONV, BCONV, ACT, DBG_WORD, bx, G, DBG_STAGE - 40); DBG_FINISH(); }
        { pg8::Gemm g{ACT, WL + WO_DN / 2, M, D, FF}; pg8::StaticOrder S; S.init(M, D, G, bx);
#ifndef NO_DN
          { EpiResid<false> E{HSB, HSB}; pg8::gemm_phase<EpiResid<false>, pg8::StaticOrder, true, true>(lds, g, S, E); }
#endif
        }
        GSYNC(); TSTAMP(8);        if (DBG_STAGE == 7) return;
    }
    {
        int tidf = threadIdx.x; asm volatile("" : "+v"(tidf));
        const int lane = tidf & 63, gw = vcu0 * NWAVES + (tidf >> 6), NGW = G0 * NWAVES;
        f32x4 g[4];
#pragma unroll
        for (int jq = 0; jq < 4; ++jq) g[jq] = ((const f32x4*)PIN(const float, 3))[lane + 64 * jq];
        float* out_ = HS; const bf16* hsb_ = HSB;
        for (int m = gw; m < M; m += NGW) {
            f32x4* xr = (f32x4*)(out_ + (size_t)m * D) + lane;
            f32x4 v[4]; float s = 0.f;
#pragma unroll
            for (int jq = 0; jq < 4; ++jq) { const u32x2 w = ((const u32x2*)(hsb_ + (size_t)m * D))[lane + 64 * jq]; v[jq] = (f32x4){bflo(w.x), bfhi(w.x), bflo(w.y), bfhi(w.y)};
                s += (v[jq].x * v[jq].x + v[jq].y * v[jq].y) + (v[jq].z * v[jq].z + v[jq].w * v[jq].w); }
            const float rstd = 1.0f / sqrtf(wave_sum(s) * (1.f / D) + NORM_EPS);
#pragma unroll
            for (int jq = 0; jq < 4; ++jq) xr[64 * jq] = v[jq] * rstd * g[jq];
        }
    }
    if (DBG_TA >= 0) {
        GSYNC(); TSTAMP(9);
        if (bx0 == 0) { const LAS unsigned* tw_ = (const LAS unsigned*)(lds + TIME_OFF); float* od_ = PIN(float, 13); int tz = threadIdx.x;
            const float va = 40.f + 5.f * log2f(0.01f * (float)tw_[DBG_TA < 0 ? 0 : DBG_TA] + 1.f), vb = 5.f * log2f(0.01f * (float)tw_[DBG_TB < 0 ? 0 : DBG_TB] + 1.f);
            for (int i = tz; i < 32768; i += NTHR) od_[i] = (i == 0) ? va : vb; }
    }
}

extern "C" void kernel_launch(void* const* d_in, const int* in_sizes, int n_in, void* d_out, int out_size, void* d_ws, size_t ws_size, hipStream_t stream) {
    static int grid = 0;
    if (grid == 0) {
        if (n_in != 13 || out_size != M * D || ws_size < WS_END) { fprintf(stderr, "kernel_launch: unexpected problem shape (n_in %d, out %d, ws %zu)\n", n_in, out_size, ws_size); grid = -1; return; }
        int dev = 0, cus = 0, per_cu = 0;
        (void)hipGetDevice(&dev); (void)hipDeviceGetAttribute(&cus, hipDeviceAttributeMultiprocessorCount, dev);
        if (hipFuncSetAttribute((const void*)fwd_kernel, hipFuncAttributeMaxDynamicSharedMemorySize, LDS_BYTES) != hipSuccess) { fprintf(stderr, "kernel_launch: hipFuncSetAttribute failed\n"); }
        if (hipOccupancyMaxActiveBlocksPerMultiprocessor(&per_cu, (const void*)fwd_kernel, NTHR, LDS_BYTES) != hipSuccess || per_cu < 1) { fprintf(stderr, "kernel_launch: occupancy query gave %d; using 1\n", per_cu); per_cu = 1; }
        (void)hipGetLastError();
        grid = cus * per_cu;
    }
    if (grid < 0) return;
    if (hipMemsetAsync((char*)d_ws + WS_BAR, 0, XCD_BAR_WORDS * 4, stream) != hipSuccess) { fprintf(stderr, "kernel_launch: hipMemsetAsync failed\n"); return; }
    Args a{};
    for (int i = 0; i < 13; ++i) a.in[i] = (const float*)d_in[i];
    a.out = (float*)d_out; a.ws = (unsigned char*)d_ws;
    void* args[] = {&a};
    const hipError_t e = hipLaunchCooperativeKernel((const void*)fwd_kernel, dim3(grid), dim3(NTHR), args, LDS_BYTES, stream);
    if (e != hipSuccess) fprintf(stderr, "kernel_launch: cooperative launch failed: %s (grid %d)\n", hipGetErrorString(e), grid);
}
```

```cpp
#include <hip/hip_runtime.h>
#include <hip/hip_cooperative_groups.h>
#include <cstdio>
#include <cstdint>
namespace cg = cooperative_groups;
namespace pg8 {
#define PG8_LAS __attribute__((address_space(3)))
typedef unsigned short bf16_t;
typedef short bf16x8 __attribute__((ext_vector_type(8)));
typedef float f32x4 __attribute__((ext_vector_type(4)));
typedef unsigned u32x4 __attribute__((ext_vector_type(4)));
constexpr int BM = 256, BK = 64, HALF = 128, HTB = HALF * BK * 2  , STAGE_BYTES = 8 * HTB, NXCD = 8, WGM = 8;

__host__ __device__ __forceinline__ int lds_byte(int r, int c) { const int st = (r >> 4) * 2 + (c >> 5), rr = r & 15, cc = c & 31, ob = rr * 64 + cc * 2; return st * 1024 + (ob ^ (((ob >> 9) & 1) << 5)); }
__host__ __device__ __forceinline__ void stage_rc(int b, int& R, int& C) { const int st = b / 1024, sb = b % 1024, swz = sb ^ (((sb >> 9) & 1) << 5); R = (st >> 1) * 16 + swz / 64; C = (st & 1) * 32 + (swz % 64) / 2; }
__host__ __device__ __forceinline__ int perm32(int rho) { const int n = rho >> 4, i = rho & 15; return 8 * (i >> 2) + 4 * n + (i & 3); }

struct Unit { int pm, pn; };
struct Gemm { const bf16_t* A; const bf16_t* Bt; int M, N, K; };

struct StaticOrder {
    int nM, nN, nwg, G, c;
    __host__ __device__ void init(int M, int N, int G_, int c_) { nM = M / BM; nN = N / BM; nwg = nM * nN; G = G_; c = c_; }
    __host__ __device__ bool next(int i, Unit& u) const {
        const long L = (long)i * G + c; if (L >= nwg) return false;
        int wgid = (int)L; { const int q = nwg / NXCD, r = nwg % NXCD, xcd = wgid % NXCD, off = wgid / NXCD; wgid = (xcd < r ? xcd * (q + 1) : r * (q + 1) + (xcd - r) * q) + off; }
        const int nig = WGM * nN, gid = wgid / nig, fm = gid * WGM, gsz = (nM - fm) < WGM ? (nM - fm) : WGM;
        u.pm = fm + ((wgid % nig) % gsz); u.pn = (wgid % nig) / gsz; return true;
    }
    __device__ __forceinline__ void a_ready(const Unit&) const {}
    __device__ __forceinline__ void done(const Unit&) const {}
};

__device__ __forceinline__ unsigned cvt_pk_bf16(float lo, float hi) { unsigned r; asm volatile("v_cvt_pk_bf16_f32 %0, %1, %2" : "=v"(r) : "v"(lo), "v"(hi)); return r; }
typedef float f32x2 __attribute__((ext_vector_type(2)));
__device__ __forceinline__ f32x2 gelu_pk(f32x2 v) {
    const f32x2 av = __builtin_elementwise_abs(v), d = av * 0.2316418882f + 1.0f;
    f32x2 t; t.x = __builtin_amdgcn_rcpf(d.x); t.y = __builtin_amdgcn_rcpf(d.y);
    f32x2 q = t * 0.5307027145f + (-0.7265760135f); q = q * t + 0.7107068705f; q = q * t + (-0.142248368f); q = q * t + 0.127414796f; q = q * t;
    const f32x2 s = (v * v) * (-0.72134752044f);
    f32x2 e; e.x = __builtin_amdgcn_exp2f(s.x); e.y = __builtin_amdgcn_exp2f(s.y);
    const f32x2 m = v * (q * e), r = v - m;
    f32x2 o; o.x = v.x < 0.f ? m.x : r.x; o.y = v.y < 0.f ? m.y : r.y; return o;
}

template <int ACT  > struct EpiBf16 {
    static constexpr bool PERM = true, AFTER_DRAIN = false; static_assert(ACT == 0 || ACT == 1, "EpiBf16: ACT is 0 (none) or 1 (gelu_pk)");
    bf16_t* O; int ldc; const float* bias; int split_cols; size_t split_stride; float scale0;
    __device__ __forceinline__ void operator()(const f32x4 (&acc)[2][2][4][2], const Unit& u, int wr, int wc, int fr, int fq) const {
        const int row0 = u.pm * BM + wr * 64 + fr; int colt = u.pn * BM; bf16_t* base = O;
        float sc = 1.f; if (split_cols) { const int t = colt / split_cols; base += (size_t)t * split_stride; colt -= t * split_cols; if (t == 0) sc = scale0; }
        const int col0 = colt + wc * 32 + 8 * fq, bcol0 = u.pn * BM + wc * 32 + 8 * fq;
        f32x4 bv[2][2];
#pragma unroll
        for (int bj = 0; bj < 2; ++bj)
#pragma unroll
            for (int n = 0; n < 2; ++n) bv[bj][n] = bias ? *(const f32x4*)(bias + bcol0 + bj * HALF + 4 * n) : (f32x4){0.f, 0.f, 0.f, 0.f};
#pragma unroll
        for (int ai = 0; ai < 2; ++ai)
#pragma unroll
            for (int m = 0; m < 4; ++m) { bf16_t* rowp = base + (size_t)(row0 + ai * HALF + m * 16) * ldc + col0;
#pragma unroll
                for (int bj = 0; bj < 2; ++bj) { f32x4 v0 = acc[ai][bj][m][0] + bv[bj][0], v1 = acc[ai][bj][m][1] + bv[bj][1];
                    if (ACT == 1) { f32x2 a = gelu_pk((f32x2){v0[0], v0[1]}), b = gelu_pk((f32x2){v0[2], v0[3]}), c = gelu_pk((f32x2){v1[0], v1[1]}), d = gelu_pk((f32x2){v1[2], v1[3]});
                        v0 = (f32x4){a.x, a.y, b.x, b.y}; v1 = (f32x4){c.x, c.y, d.x, d.y}; }
                    v0 = v0 * sc; v1 = v1 * sc; u32x4 w; w.x = cvt_pk_bf16(v0[0], v0[1]); w.y = cvt_pk_bf16(v0[2], v0[3]); w.z = cvt_pk_bf16(v1[0], v1[1]); w.w = cvt_pk_bf16(v1[2], v1[3]);
                    *(u32x4*)(rowp + bj * HALF) = w; } }
    }
};
template <class Epi, class Sched, bool ALIGN_EPI = false, bool SP2 = false>
__device__ __forceinline__ void gemm_phase(PG8_LAS unsigned char* lds, const Gemm g, const Sched& S, const Epi& E) {
    int tid_ = threadIdx.x; asm volatile("" : "+v"(tid_));
    const int tid = tid_, wid = __builtin_amdgcn_readfirstlane(tid >> 6), lane = tid & 63, wr = wid >> 2, wc = wid & 3, fr = lane & 15, fq = lane >> 4;
    const int K = g.K, nt = K / BK;
    unsigned voffA[2], voffB[2];
#pragma unroll
    for (int i = 0; i < 2; ++i) { int R, C; stage_rc(tid * 16 + i * 8192, R, C); const int Rb = Epi::PERM ? ((R & ~31) + perm32(R & 31)) : R;
        voffA[i] = (unsigned)(R * K + C) * 2u; voffB[i] = (unsigned)(Rb * K + C) * 2u; }
    const size_t kstep = (size_t)(BK * 2);
    const size_t hstep = (size_t)HALF * K * 2;
    const size_t tstep = 2 * hstep;
    const unsigned ldsw = (unsigned)wid * 1024u;
    const int aoff = lds_byte(wr * 64 + fr, fq * 8), boff = lds_byte(wc * 32 + fr, fq * 8);
#define PG8_SA(b, h) (((b) * 2 + (h)) * HTB)
#define PG8_SB(b, h) ((4 + (b) * 2 + (h)) * HTB)
#define PG8_STAGE(bufoff, gbase, voff) do { _Pragma("unroll") for (int _i = 0; _i < 2; ++_i) \
        __builtin_amdgcn_global_load_lds((const unsigned*)((const char*)(gbase) + (voff)[_i]), (PG8_LAS unsigned*)(lds + (bufoff) + ldsw + _i * 8192), 16, 0, 0); } while (0)
#define PG8_LDA(dst, b, h) do { _Pragma("unroll") for (int m = 0; m < 4; ++m) _Pragma("unroll") for (int k = 0; k < 2; ++k) dst[m][k] = *(const PG8_LAS bf16x8*)(lds + PG8_SA(b, h) + aoff + m * 2048 + k * 1024); } while (0)
#define PG8_LDB(dst, b, h) do { _Pragma("unroll") for (int n = 0; n < 2; ++n) _Pragma("unroll") for (int k = 0; k < 2; ++k) dst[n][k] = *(const PG8_LAS bf16x8*)(lds + PG8_SB(b, h) + boff + n * 2048 + k * 1024); } while (0)
#define PG8_MMA(ai, bj, At, Bt) do { __builtin_amdgcn_s_setprio(1); _Pragma("unroll") for (int m = 0; m < 4; ++m) _Pragma("unroll") for (int n = 0; n < 2; ++n) _Pragma("unroll") for (int k = 0; k < 2; ++k) \
        acc[ai][bj][m][n] = __builtin_amdgcn_mfma_f32_16x16x32_bf16(Bt[n][k], At[m][k], acc[ai][bj][m][n], 0, 0, 0); __builtin_amdgcn_s_setprio(0); } while (0)
#define PG8_WAIT_V(n) asm volatile("s_waitcnt vmcnt(" #n ")" ::: "memory")
#define PG8_WAIT_L(n) asm volatile("s_waitcnt lgkmcnt(" #n ")" ::: "memory")
#define PG8_BAR __builtin_amdgcn_s_barrier()
#define PG8_SCHED __builtin_amdgcn_sched_barrier(0)
    Unit cur, nxt; int ui = 0;
    if (!S.next(0, cur)) return;
    f32x4 acc[2][2][4][2];
#pragma unroll
    for (int a = 0; a < 2; ++a)
#pragma unroll
        for (int b = 0; b < 2; ++b)
#pragma unroll
            for (int m = 0; m < 4; ++m)
#pragma unroll
                for (int n = 0; n < 2; ++n) acc[a][b][m][n] = (f32x4){0.f, 0.f, 0.f, 0.f};
    bf16x8 At[4][2], B0[2][2], B1[2][2];
    const char* cA = (const char*)g.A + (size_t)cur.pm * tstep; const char* cB = (const char*)g.Bt + (size_t)cur.pn * tstep;
    S.a_ready(cur);
    if constexpr (SP2) {
        PG8_STAGE(PG8_SB(0, 0), cB, voffB); PG8_STAGE(PG8_SB(0, 1), cB + hstep, voffB); PG8_STAGE(PG8_SA(0, 0), cA, voffA); PG8_STAGE(PG8_SA(0, 1), cA + hstep, voffA);
        if (wr == 1) PG8_BAR;
        PG8_WAIT_V(2); PG8_BAR;
        PG8_STAGE(PG8_SB(1, 0), cB + kstep, voffB); PG8_STAGE(PG8_SA(1, 0), cA + kstep, voffA); PG8_STAGE(PG8_SB(1, 1), cB + hstep + kstep, voffB);
        PG8_WAIT_V(6); PG8_BAR;
    } else {
        PG8_STAGE(PG8_SB(0, 0), cB, voffB); PG8_STAGE(PG8_SA(0, 0), cA, voffA); PG8_STAGE(PG8_SB(0, 1), cB + hstep, voffB); PG8_STAGE(PG8_SA(0, 1), cA + hstep, voffA);
        if (wr == 1) PG8_BAR;
        PG8_WAIT_V(4); PG8_BAR;
        PG8_STAGE(PG8_SB(1, 0), cB + kstep, voffB); PG8_STAGE(PG8_SA(1, 0), cA + kstep, voffA); PG8_STAGE(PG8_SB(1, 1), cB + hstep + kstep, voffB);
        PG8_WAIT_V(6); PG8_BAR;
    }
    for (;;) {
        const bool has_next = S.next(ui + 1, nxt);
        const char* nA = has_next ? (const char*)g.A + (size_t)nxt.pm * tstep : cA; const char* nB = has_next ? (const char*)g.Bt + (size_t)nxt.pn * tstep : cB;
        for (int t = 0; t < nt; t += 2) {
            const bool last = (t == nt - 2);
            const char* a1 = cA + (size_t)(t + 1) * kstep;
            const char* a2 = last ? nA : cA + (size_t)(t + 2) * kstep; const char* b2 = last ? nB : cB + (size_t)(t + 2) * kstep;
            const char* a3 = a2 + kstep; const char* b3 = b2 + kstep;
            if (last && has_next) S.a_ready(nxt);
            if constexpr (SP2) {
            PG8_LDB(B0, 0, 0); PG8_LDB(B1, 0, 1); PG8_SCHED; PG8_LDA(At, 0, 0); PG8_STAGE(PG8_SA(1, 1), a1 + hstep, voffA);
            PG8_WAIT_V(8); PG8_WAIT_L(0); PG8_BAR; PG8_MMA(0, 0, At, B0); PG8_MMA(0, 1, At, B1); PG8_BAR; PG8_SCHED;
            PG8_LDA(At, 0, 1); PG8_STAGE(PG8_SB(0, 0), b2, voffB); PG8_STAGE(PG8_SB(0, 1), b2 + hstep, voffB); PG8_STAGE(PG8_SA(0, 0), a2, voffA);
            PG8_WAIT_V(8); PG8_WAIT_L(0); PG8_BAR; PG8_MMA(1, 0, At, B0); PG8_MMA(1, 1, At, B1); PG8_BAR; PG8_SCHED;
            PG8_LDB(B0, 1, 0); PG8_LDB(B1, 1, 1); PG8_SCHED; PG8_LDA(At, 1, 0); PG8_STAGE(PG8_SA(0, 1), a2 + hstep, voffA);
            PG8_WAIT_V(8); PG8_WAIT_L(0); PG8_BAR; PG8_MMA(0, 0, At, B0); PG8_MMA(0, 1, At, B1); PG8_BAR; PG8_SCHED;
            PG8_LDA(At, 1, 1); PG8_STAGE(PG8_SB(1, 0), b3, voffB); PG8_STAGE(PG8_SB(1, 1), b3 + hstep, voffB); PG8_STAGE(PG8_SA(1, 0), a3, voffA);
            PG8_WAIT_V(8); PG8_WAIT_L(0); PG8_BAR; PG8_MMA(1, 0, At, B0); PG8_MMA(1, 1, At, B1); PG8_BAR; PG8_SCHED;
            } else {
            PG8_LDB(B0, 0, 0); PG8_SCHED; PG8_LDA(At, 0, 0); PG8_STAGE(PG8_SA(1, 1), a1 + hstep, voffA);
            PG8_WAIT_L(8); PG8_BAR; PG8_WAIT_L(0); PG8_MMA(0, 0, At, B0); PG8_BAR; PG8_SCHED;
            PG8_LDB(B1, 0, 1); PG8_STAGE(PG8_SB(0, 0), b2, voffB);
            PG8_BAR; PG8_WAIT_L(0); PG8_MMA(0, 1, At, B1); PG8_BAR;
            PG8_LDA(At, 0, 1); PG8_STAGE(PG8_SA(0, 0), a2, voffA);
            PG8_BAR; PG8_WAIT_L(0); PG8_MMA(1, 0, At, B0); PG8_BAR; PG8_SCHED;
            PG8_STAGE(PG8_SB(0, 1), b2 + hstep, voffB);
            PG8_WAIT_V(6); PG8_BAR; PG8_MMA(1, 1, At, B1); PG8_BAR;
            PG8_LDB(B0, 1, 0); PG8_SCHED; PG8_LDA(At, 1, 0); PG8_STAGE(PG8_SA(0, 1), a2 + hstep, voffA);
            PG8_WAIT_L(8); PG8_BAR; PG8_WAIT_L(0); PG8_MMA(0, 0, At, B0); PG8_BAR; PG8_SCHED;
            PG8_LDB(B1, 1, 1); PG8_STAGE(PG8_SB(1, 0), b3, voffB);
            PG8_BAR; PG8_WAIT_L(0); PG8_MMA(0, 1, At, B1); PG8_BAR;
            PG8_LDA(At, 1, 1); PG8_STAGE(PG8_SA(1, 0), a3, voffA);
            PG8_BAR; PG8_WAIT_L(0); PG8_MMA(1, 0, At, B0); PG8_BAR; PG8_SCHED;
            PG8_STAGE(PG8_SB(1, 1), b3 + hstep, voffB);
            PG8_WAIT_V(6); PG8_BAR; PG8_MMA(1, 1, At, B1); PG8_BAR;
            }
        }
        if constexpr (ALIGN_EPI) { if (wr == 0) PG8_BAR; }
        if constexpr (!Epi::AFTER_DRAIN) { E(acc, cur, wr, wc, fr, fq); S.done(cur); }
        if (!has_next) break;
#pragma unroll
        for (int a = 0; a < 2; ++a)
#pragma unroll
            for (int b = 0; b < 2; ++b)
#pragma unroll
                for (int m = 0; m < 4; ++m)
#pragma unroll
                    for (int n = 0; n < 2; ++n) acc[a][b][m][n] = (f32x4){0.f, 0.f, 0.f, 0.f};
        cur = nxt; cA = nA; cB = nB; ++ui;
        if constexpr (ALIGN_EPI) { if (wr == 1) PG8_BAR; }
    }
    PG8_WAIT_V(0);
    if constexpr (!ALIGN_EPI) { if (wr == 0) PG8_BAR; }
    PG8_BAR;
    if constexpr (Epi::AFTER_DRAIN) { E.fused(acc, cur, wr, wc, fr, fq, lds, wid, lane); S.done(cur); }
#undef PG8_SA
#undef PG8_SB
#undef PG8_STAGE
#undef PG8_LDA
#undef PG8_LDB
#undef PG8_MMA
#undef PG8_WAIT_V
#undef PG8_WAIT_L
#undef PG8_BAR
#undef PG8_SCHED
}
}
#ifndef DBG_STAGE
#define DBG_STAGE 0
#endif
#ifndef DBG_SKIP
#define DBG_SKIP 0
#endif
constexpr int BATCH = 8, SEQ = 4096, D = 1024, NH = 16, HD = 64, FF = 2816, FF2 = 2 * FF, DEPTH = 4;
constexpr int M = BATCH * SEQ;
constexpr float NORM_EPS = 1e-6f;
constexpr float LOG2E = 1.4426950408889634f;
constexpr float QSCALE = 0.125f * LOG2E;
constexpr int NWAVES = 8, NTHR = 512;

#define LAS __attribute__((address_space(3)))
typedef unsigned short bf16;
typedef float f32x4 __attribute__((ext_vector_type(4)));
typedef float f32x16 __attribute__((ext_vector_type(16)));
typedef short bf16x8 __attribute__((ext_vector_type(8)));
typedef unsigned u32x4 __attribute__((ext_vector_type(4)));
typedef unsigned u32x2 __attribute__((ext_vector_type(2)));

constexpr size_t MiB = 1u << 20;
constexpr size_t W_LAYER = 25 * MiB;
constexpr size_t WO_QK = 0, WO_V = 4 * MiB, WO_O = 6 * MiB, WO_UP = 8 * MiB, WO_DN = 19 * MiB;
constexpr size_t WS_W = 0;
constexpr size_t WS_BAR = 99 * MiB + 576 * 1024;
constexpr size_t WS_FLOG = 100 * MiB;
constexpr size_t WS_C2 = 102 * MiB;
constexpr size_t WS_EDGE = 104 * MiB;
constexpr size_t WS_RAW01 = 110 * MiB;
constexpr size_t WS_XN = 116 * MiB;
constexpr size_t WS_QO = 180 * MiB;
constexpr size_t WS_K = 244 * MiB;
constexpr size_t WS_VT = 308 * MiB;
constexpr size_t WS_ACT = 180 * MiB;
constexpr size_t WS_HSB = 372 * MiB;
constexpr size_t WS_END = 436 * MiB;
static_assert(WS_ACT + (size_t)M * FF * 2 <= WS_END, "ws map");

constexpr int RING_BYTES = 131072, XCH_OFF = RING_BYTES, MISC_OFF = XCH_OFF + 8192, PTAB_OFF = MISC_OFF + 256, TIME_OFF = MISC_OFF + 512, WL_OFF = MISC_OFF + 1024, LDS_BYTES = 147456;

typedef float f32x2_t __attribute__((ext_vector_type(2))); typedef __bf16 bf16x2_t __attribute__((ext_vector_type(2)));
__device__ __forceinline__ unsigned cvtpk(float lo, float hi) { f32x2_t v = {lo, hi}; bf16x2_t b = __builtin_convertvector(v, bf16x2_t); return __builtin_bit_cast(unsigned, b); }
__device__ __forceinline__ float wave_sum(float v) {
#pragma unroll
    for (int o = 1; o < 64; o <<= 1) v += __shfl_xor(v, o);
    return v;
}
__device__ __forceinline__ float ex2(float x) { return __builtin_amdgcn_exp2f(x); }
__device__ __forceinline__ float lg2(float x) { return __builtin_amdgcn_logf(x); }
__device__ __forceinline__ float bflo(unsigned w) { return __uint_as_float(w << 16); }
__device__ __forceinline__ float bfhi(unsigned w) { return __uint_as_float(w & 0xffff0000u); }
template <bool BASE_F32>
struct EpiResid {
    static constexpr bool PERM = true, AFTER_DRAIN = false;
    const void* base; bf16* out;
    __device__ __forceinline__ void operator()(const pg8::f32x4 (&acc)[2][2][4][2], const pg8::Unit& u, int wr, int wc, int fr, int fq) const {
        const int row0 = u.pm * 256 + wr * 64 + fr, col0 = u.pn * 256 + wc * 32 + 8 * fq;
#pragma unroll
        for (int ai = 0; ai < 2; ++ai)
#pragma unroll
            for (int m = 0; m < 4; ++m) { const size_t off = (size_t)(row0 + ai * 128 + m * 16) * D + col0;
#pragma unroll
                for (int bj = 0; bj < 2; ++bj) { f32x4 b0, b1;
                    if (BASE_F32) { b0 = *(const f32x4*)((const float*)base + off + bj * 128); b1 = *(const f32x4*)((const float*)base + off + bj * 128 + 4); }
                    else { const u32x4 w = *(const u32x4*)((const bf16*)base + off + bj * 128); b0 = (f32x4){bflo(w.x), bfhi(w.x), bflo(w.y), bfhi(w.y)}; b1 = (f32x4){bflo(w.z), bfhi(w.z), bflo(w.w), bfhi(w.w)}; }
                    const f32x4 r0 = b0 + acc[ai][bj][m][0], r1 = b1 + acc[ai][bj][m][1];
                    u32x4 o; o.x = cvtpk(r0[0], r0[1]); o.y = cvtpk(r0[2], r0[3]); o.z = cvtpk(r1[0], r1[1]); o.w = cvtpk(r1[2], r1[3]);
                    *(u32x4*)(out + off + bj * 128) = o; }
                asm volatile("" ::: "memory"); }
    }
};

__device__ __forceinline__ float dpp_ror1(float v) { return __builtin_bit_cast(float, __builtin_amdgcn_mov_dpp(__builtin_bit_cast(int, v), 0x121, 0xf, 0xf, false)); }
__device__ __forceinline__ float dpp_shr1_old(float old_, float v) { return __builtin_bit_cast(float, __builtin_amdgcn_update_dpp(__builtin_bit_cast(int, old_), __builtin_bit_cast(int, v), 0x111, 0xf, 0xf, false)); }
__device__ __forceinline__ float dpp_shr2_old(float old_, float v) { return __builtin_bit_cast(float, __builtin_amdgcn_update_dpp(__builtin_bit_cast(int, old_), __builtin_bit_cast(int, v), 0x112, 0xf, 0xf, false)); }
__device__ __forceinline__ float dpp_ror2(float v) { return __builtin_bit_cast(float, __builtin_amdgcn_mov_dpp(__builtin_bit_cast(int, v), 0x122, 0xf, 0xf, false)); }

struct EpiConvGate {
    static constexpr bool PERM = true, AFTER_DRAIN = false;
    bf16* act; const float* wconv; const float* bconv; float* edge; float* raw01; LAS float* xch;
    __device__ __forceinline__ void operator()(const pg8::f32x4 (&acc)[2][2][4][2], const pg8::Unit& u, int wr, int wc, int fr, int fq) const {
        const int lc0 = wc * 32 + 8 * fq, ch0 = u.pn * 128 + lc0;
        if (fr >= 14) {
#pragma unroll
            for (int ai = 0; ai < 2; ++ai) { const int q = 2 * ai + wr;
#pragma unroll
                for (int bj = 0; bj < 2; ++bj)
#pragma unroll
                    for (int n = 0; n < 2; ++n) *(LAS f32x4*)(xch + (q * 2 + (fr - 14)) * 256 + bj * 128 + lc0 + 4 * n) = acc[ai][bj][3][n]; }
            if (wr == 1) {
#pragma unroll
                for (int bj = 0; bj < 2; ++bj)
#pragma unroll
                    for (int n = 0; n < 2; ++n) *(f32x4*)(edge + ((size_t)u.pm * 2 + (fr - 14)) * FF2 + bj * FF + ch0 + 4 * n) = acc[1][bj][3][n]; }
        }
        if (wr == 0 && fr < 2) {
#pragma unroll
            for (int bj = 0; bj < 2; ++bj)
#pragma unroll
                for (int n = 0; n < 2; ++n) *(f32x4*)(raw01 + ((size_t)u.pm * 2 + fr) * FF2 + bj * FF + ch0 + 4 * n) = acc[0][bj][0][n];
        }
        asm volatile("s_waitcnt lgkmcnt(0)" ::: "memory"); __builtin_amdgcn_s_barrier(); asm volatile("" ::: "memory");
#pragma unroll
        for (int n = 0; n < 2; ++n) {
            const f32x4 wu0 = *(const f32x4*)(wconv + ch0 + 4 * n), wu1 = *(const f32x4*)(wconv + FF2 + ch0 + 4 * n), wu2 = *(const f32x4*)(wconv + 2 * FF2 + ch0 + 4 * n), bu = *(const f32x4*)(bconv + ch0 + 4 * n);
            const f32x4 wg0 = *(const f32x4*)(wconv + FF + ch0 + 4 * n), wg1 = *(const f32x4*)(wconv + FF2 + FF + ch0 + 4 * n), wg2 = *(const f32x4*)(wconv + 2 * FF2 + FF + ch0 + 4 * n), bg = *(const f32x4*)(bconv + FF + ch0 + 4 * n);
#pragma unroll
            for (int ai = 0; ai < 2; ++ai) {
                const int q = 2 * ai + wr;
                f32x4 pru = (f32x4){0.f, 0.f, 0.f, 0.f}, prg = pru;
                if (q > 0 && fr >= 14) { pru = *(const LAS f32x4*)(xch + ((q - 1) * 2 + (fr - 14)) * 256 + lc0 + 4 * n); prg = *(const LAS f32x4*)(xch + ((q - 1) * 2 + (fr - 14)) * 256 + 128 + lc0 + 4 * n); }
#pragma unroll
                for (int m = 0; m < 4; ++m) {
                    float r4[4];
#pragma unroll
                    for (int j = 0; j < 4; ++j) {
                        const float vu = acc[ai][0][m][n][j], vg = acc[ai][1][m][n][j];
                        const float pu = m > 0 ? acc[ai][0][m > 0 ? m - 1 : 0][n][j] : pru[j];
                        const float pg = m > 0 ? acc[ai][1][m > 0 ? m - 1 : 0][n][j] : prg[j];
                        const float u1 = dpp_shr1_old(dpp_ror1(pu), vu), u2 = dpp_shr2_old(dpp_ror2(pu), vu);
                        const float g1 = dpp_shr1_old(dpp_ror1(pg), vg), g2 = dpp_shr2_old(dpp_ror2(pg), vg);
                        const float nb = (DBG_STAGE == 21) ? 0.f : 1.f;
                        const float hu = bu[j] + wu2[j] * vu + nb * (wu1[j] * u1 + wu0[j] * u2);
                        const float hg = bg[j] + wg2[j] * vg + nb * (wg1[j] * g1 + wg0[j] * g2);
                        const float sg = hg * __builtin_amdgcn_rcpf(1.f + ex2(-hg * LOG2E));
                        r4[j] = sg * hu;
                    }
                    const int row = u.pm * 256 + ai * 128 + wr * 64 + m * 16 + fr;
                    u32x2 w; w.x = cvtpk(r4[0], r4[1]); w.y = cvtpk(r4[2], r4[3]);
                    if (!(ai == 0 && m == 0 && wr == 0 && fr < 2)) *(u32x2*)(act + (size_t)row * FF + ch0 + 4 * n) = w;
                    asm volatile("" ::: "memory");
                }
            }
        }
    }
};
constexpr int A_ROWB = 144, A_KBUF = 64 * A_ROWB, A_OFF_K = 0, A_OFF_V = 2 * A_KBUF, A_OFF_FLAG = 5 * A_KBUF;

__device__ __forceinline__ float lane_partner(float v, int hi) {
    auto rr = __builtin_amdgcn_permlane32_swap(__float_as_uint(v), __float_as_uint(v), false, false);
    return __uint_as_float(hi ? rr[0] : rr[1]);
}

template <int MODE>
__device__ __forceinline__ void attn_unit(int b, int h, int qb, const bf16* Q, const bf16* __restrict__ K, const bf16* __restrict__ VT, const float* __restrict__ C2, bf16* O, LAS unsigned char* lds) {
    int tid_ = threadIdx.x; asm volatile("" : "+v"(tid_));
    const int tid = tid_, lane = tid & 63, r32 = lane & 31, hi = lane >> 5; const int wid = __builtin_amdgcn_readfirstlane(tid >> 6);
    const size_t rowbase = (size_t)b * SEQ; const int q0 = qb * 256; const int NT = (q0 + 256) / 64;
    const int qabs = q0 + wid * 32 + r32;
    const bf16* Qw = Q + (rowbase + qabs) * D + h * 64;
    bf16x8 qr[4];
#pragma unroll
    for (int d0 = 0; d0 < 4; ++d0) qr[d0] = *(const bf16x8*)(Qw + d0 * 16 + hi * 8);
    const int lrow = tid >> 3, lch = tid & 7;
    const bf16* ksrc = K + (rowbase + lrow) * D + h * 64 + lch * 8;
    const bf16* vsrc = VT + (size_t)(h * 64 + lrow) * M + rowbase + lch * 8;
    const float* csrc = C2 + ((size_t)(b * NH + h)) * SEQ + lrow;
    const int ldst = lrow * A_ROWB + lch * 16;
    const int krow = (r32 & ~12) | ((r32 & 4) << 1) | ((r32 & 8) >> 1);
    const int koff = krow * A_ROWB + hi * 16, voff = r32 * A_ROWB + hi * 16;
    u32x4 kregs[2], vregs[2]; float cregs[2] = {0.f, 0.f};
#define A_TILE(i) (NT - 1 - (i))
#define A_LOAD(t, S) do { kregs[S] = *(const u32x4*)(ksrc + (size_t)(t) * 64 * D); vregs[S] = *(const u32x4*)(vsrc + (t) * 64); if (MODE == 0) cregs[S] = csrc[(t) * 64]; } while (0)
#define A_WRITE(buf, vbuf_, S) do { *(LAS u32x4*)(lds + A_OFF_K + (buf) * A_KBUF + ldst) = kregs[S]; *(LAS u32x4*)(lds + A_OFF_V + (vbuf_) * A_KBUF + ldst) = vregs[S]; \
        if (MODE == 0 && lch == 0) { const float nb_ = -cregs[S]; const unsigned hb_ = cvtpk(nb_, 0.f) & 0xffffu; const float rem_ = nb_ - __uint_as_float(hb_ << 16); \
            *(LAS u32x4*)(lds + A_OFF_K + (buf) * A_KBUF + lrow * A_ROWB + 128) = (u32x4){hb_ | (cvtpk(rem_, 0.f) << 16), 0u, 0u, 0u}; } } while (0)
    f32x16 o0, o1;
#pragma unroll
    for (int r = 0; r < 16; ++r) { o0[r] = 0.f; o1[r] = 0.f; }
    float mrun = -INFINITY, lrun = 0.f, carry = 1.f;
    f32x16 negm; bool started = false;
#pragma unroll
    for (int r = 0; r < 16; ++r) negm[r] = 0.f;
    const bf16x8 qone = hi ? (bf16x8){0, 0, 0, 0, 0, 0, 0, 0} : (bf16x8){0x3f80, 0x3f80, 0, 0, 0, 0, 0, 0};
    if (MODE == 0 && tid == 0) *(LAS u32x4*)(lds + A_OFF_FLAG + 64) = (u32x4){0u, 0u, 0u, 0u};
    A_LOAD(A_TILE(0), 0); A_WRITE(0, 0, 0);
    A_LOAD(A_TILE(1), 1);
    asm volatile("" : "+v"(qr[0]), "+v"(qr[1]), "+v"(qr[2]), "+v"(qr[3]));
    __syncthreads();
    const bool lag = true; bool pend = false; bf16x8 P[4];
#pragma unroll
    for (int ii = 0; ii < 4; ++ii) P[ii] = (bf16x8){0, 0, 0, 0, 0, 0, 0, 0};
    int vbuf = 0, vprev = 0;
#define A_PV(vslot) do { const LAS unsigned char* vb_ = lds + A_OFF_V + (vslot) * A_KBUF; bf16x8 vf0_[4], vf1_[4]; \
        _Pragma("unroll") for (int ii = 0; ii < 4; ++ii) { vf0_[ii] = *(const LAS bf16x8*)(vb_ + voff + ii * 32); vf1_[ii] = *(const LAS bf16x8*)(vb_ + 32 * A_ROWB + voff + ii * 32); } \
        __builtin_amdgcn_sched_barrier(0);     \
        __builtin_amdgcn_s_setprio(1); \
        _Pragma("unroll") for (int ii = 0; ii < 4; ++ii) { o0 = __builtin_amdgcn_mfma_f32_32x32x16_bf16(vf0_[ii], P[ii], o0, 0, 0, 0); o1 = __builtin_amdgcn_mfma_f32_32x32x16_bf16(vf1_[ii], P[ii], o1, 0, 0, 0); } \
        __builtin_amdgcn_s_setprio(0); } while (0)
    bool stop = false, wdone = false;
    for (int ip = 0; ip < NT / 2 && !stop; ++ip) {
#pragma unroll
    for (int sub = 0; sub < 2; ++sub) {
        const int i = 2 * ip + sub;
        const int buf = sub, t = A_TILE(i);
        { const int t2_ = A_TILE(i + 2); A_LOAD(t2_ < 0 ? 0 : t2_, sub); }
        const LAS unsigned char* kb = lds + A_OFF_K + buf * A_KBUF;
        const bool vis_ = 64 * t <= q0 + wid * 32 + 31 && !(MODE == 1 && wdone);
        if (MODE == 1 && pend && !vis_) { A_PV(vprev); pend = false;
#pragma unroll
            for (int ii = 0; ii < 4; ++ii) P[ii] = (bf16x8){0, 0, 0, 0, 0, 0, 0, 0}; }
        if (vis_) {
        f32x16 s0, s1;
        {
            bf16x8 kf0_[5], kf1_[5];
#pragma unroll
            for (int d0 = 0; d0 < 4; ++d0) { kf0_[d0] = *(const LAS bf16x8*)(kb + koff + d0 * 32); kf1_[d0] = *(const LAS bf16x8*)(kb + 32 * A_ROWB + koff + d0 * 32); }
            if (MODE == 0) {
                const LAS unsigned char* zp = lds + A_OFF_FLAG + 64;
                const LAS unsigned char* p0 = hi ? zp : kb + krow * A_ROWB + 128; const LAS unsigned char* p1 = hi ? zp : kb + (krow + 32) * A_ROWB + 128;
                kf0_[4] = *(const LAS bf16x8*)p0; kf1_[4] = *(const LAS bf16x8*)p1;
            }
            __builtin_amdgcn_sched_barrier(0);
            __builtin_amdgcn_s_setprio(1);
            s0 = __builtin_amdgcn_mfma_f32_32x32x16_bf16(kf0_[0], qr[0], negm, 0, 0, 0);
            s1 = __builtin_amdgcn_mfma_f32_32x32x16_bf16(kf1_[0], qr[0], negm, 0, 0, 0);
#pragma unroll
            for (int d0 = 1; d0 < 4; ++d0) {
                s0 = __builtin_amdgcn_mfma_f32_32x32x16_bf16(kf0_[d0], qr[d0], s0, 0, 0, 0);
                s1 = __builtin_amdgcn_mfma_f32_32x32x16_bf16(kf1_[d0], qr[d0], s1, 0, 0, 0);
            }
            if (MODE == 0) {
                s0 = __builtin_amdgcn_mfma_f32_32x32x16_bf16(kf0_[4], qone, s0, 0, 0, 0);
                s1 = __builtin_amdgcn_mfma_f32_32x32x16_bf16(kf1_[4], qone, s1, 0, 0, 0);
            }
            __builtin_amdgcn_s_setprio(0);
        }
        const bool band = t >= NT - 4;
        const int kbase = t * 64 + 8 * hi;
        if (MODE == 0) {
            if (band) {
#pragma unroll
                for (int r = 0; r < 16; ++r) { const int key = kbase + (r & 7) + 16 * (r >> 3); if (key > qabs) s0[r] = -INFINITY; if (key + 32 > qabs) s1[r] = -INFINITY; }
            }
            float mx = __builtin_fmaxf(s0[0], s1[0]);
#pragma unroll
            for (int r = 1; r < 16; ++r) mx = __builtin_fmaxf(__builtin_fmaxf(mx, s0[r]), s1[r]);
            mx = fmaxf(mx, lane_partner(mx, hi));
            if (!started) {
                started = true; mrun = mx;
#pragma unroll
                for (int r = 0; r < 16; ++r) { s0[r] -= mx; s1[r] -= mx; negm[r] = -mx; }
            } else if (__any(mx > 0.f)) {
                if (pend) { A_PV(vprev); pend = false;
#pragma unroll
                    for (int ii = 0; ii < 4; ++ii) P[ii] = (bf16x8){0, 0, 0, 0, 0, 0, 0, 0}; }
                const float dl = fmaxf(mx, 0.f), alpha = ex2(-dl);
                lrun *= alpha; mrun += dl;
#pragma unroll
                for (int r = 0; r < 16; ++r) { o0[r] *= alpha; o1[r] *= alpha; s0[r] -= dl; s1[r] -= dl; negm[r] -= dl; }
            }
            {
                const LAS unsigned char* vb_ = lds + A_OFF_V + (pend ? vprev : vbuf) * A_KBUF;
                bf16x8 vf0_[4], vf1_[4];
#pragma unroll
                for (int ii = 0; ii < 4; ++ii) { vf0_[ii] = *(const LAS bf16x8*)(vb_ + voff + ii * 32); vf1_[ii] = *(const LAS bf16x8*)(vb_ + 32 * A_ROWB + voff + ii * 32); }
                float ls = 0.f; bf16x8 Pn[4];
#pragma unroll
                for (int ii = 0; ii < 4; ++ii) {
                    o0 = __builtin_amdgcn_mfma_f32_32x32x16_bf16(vf0_[ii], P[ii], o0, 0, 0, 0); o1 = __builtin_amdgcn_mfma_f32_32x32x16_bf16(vf1_[ii], P[ii], o1, 0, 0, 0);
                    float pv_[8];
#pragma unroll
                    for (int e = 0; e < 8; ++e) { pv_[e] = ex2(ii < 2 ? s0[8 * (ii & 1) + e] : s1[8 * (ii & 1) + e]); ls += pv_[e]; }
                    u32x4 w; w.x = cvtpk(pv_[0], pv_[1]); w.y = cvtpk(pv_[2], pv_[3]); w.z = cvtpk(pv_[4], pv_[5]); w.w = cvtpk(pv_[6], pv_[7]);
                    Pn[ii] = __builtin_bit_cast(bf16x8, w);
                    __builtin_amdgcn_sched_barrier(0);
                }
                lrun += ls; pend = true;
#pragma unroll
                for (int ii = 0; ii < 4; ++ii) P[ii] = Pn[ii];
            }
        } else {
            f32x16 b0, b1;
            {
                const LAS unsigned char* vb_ = lds + A_OFF_V + (pend ? vprev : vbuf) * A_KBUF;
                bf16x8 vf0_[4], vf1_[4];
#pragma unroll
                for (int ii = 0; ii < 4; ++ii) { vf0_[ii] = *(const LAS bf16x8*)(vb_ + voff + ii * 32); vf1_[ii] = *(const LAS bf16x8*)(vb_ + 32 * A_ROWB + voff + ii * 32); }
#pragma unroll
                for (int ii = 0; ii < 4; ++ii) {
                    o0 = __builtin_amdgcn_mfma_f32_32x32x16_bf16(vf0_[ii], P[ii], o0, 0, 0, 0); o1 = __builtin_amdgcn_mfma_f32_32x32x16_bf16(vf1_[ii], P[ii], o1, 0, 0, 0);
#pragma unroll
                    for (int e = 0; e < 8; ++e) { const int r = 8 * (ii & 1) + e;
                        if (ii < 2) { const float z = fmaxf(s0[r], -100.f), ee = ex2(-z), rr = __builtin_amdgcn_rcpf(1.f + ee); b0[r] = ee * rr; s0[r] = rr; }
                        else        { const float z = fmaxf(s1[r], -100.f), ee = ex2(-z), rr = __builtin_amdgcn_rcpf(1.f + ee); b1[r] = ee * rr; s1[r] = rr; } }
                    __builtin_amdgcn_sched_barrier(0);
                }
                pend = false;
            }
            if (band) {
#pragma unroll
                for (int r = 0; r < 16; ++r) { const int key = kbase + (r & 7) + 16 * (r >> 3);
                    if (key >= qabs) { b0[r] = 1.f; s0[r] = 0.f; } if (key + 32 >= qabs) { b1[r] = 1.f; s1[r] = 0.f; } }
            }
            float T[4];
#pragma unroll
            for (int a = 0; a < 4; ++a) { float tt = 1.f;
#pragma unroll
                for (int e = 0; e < 8; ++e) tt *= (a < 2 ? b0[8 * (a & 1) + e] : b1[8 * (a & 1) + e]);
                T[a] = tt; }
            float U[4], tot[4];
#pragma unroll
            for (int a = 0; a < 4; ++a) { U[a] = lane_partner(T[a], hi); tot[a] = T[a] * U[a]; }
            float later = carry;
#pragma unroll
            for (int a = 3; a >= 0; --a) {
                float run = later * (hi == 0 ? U[a] : 1.f);
#pragma unroll
                for (int e = 7; e >= 0; --e) {
                    if (a < 2) { const float lb = b0[8 * (a & 1) + e]; s0[8 * (a & 1) + e] *= run; run *= lb; }
                    else       { const float lb = b1[8 * (a & 1) + e]; s1[8 * (a & 1) + e] *= run; run *= lb; }
                }
                later *= tot[a];
            }
            carry = later;
        }
        if (MODE == 1) {
#pragma unroll
        for (int ii = 0; ii < 4; ++ii) { u32x4 w;
            if (ii < 2) { w.x = cvtpk(s0[8 * ii], s0[8 * ii + 1]); w.y = cvtpk(s0[8 * ii + 2], s0[8 * ii + 3]); w.z = cvtpk(s0[8 * ii + 4], s0[8 * ii + 5]); w.w = cvtpk(s0[8 * ii + 6], s0[8 * ii + 7]); }
            else { const int i2 = ii - 2; w.x = cvtpk(s1[8 * i2], s1[8 * i2 + 1]); w.y = cvtpk(s1[8 * i2 + 2], s1[8 * i2 + 3]); w.z = cvtpk(s1[8 * i2 + 4], s1[8 * i2 + 5]); w.w = cvtpk(s1[8 * i2 + 6], s1[8 * i2 + 7]); }
            P[ii] = __builtin_bit_cast(bf16x8, w); }
        pend = true;
        }
        }
        vprev = vbuf; vbuf = (vbuf == 2) ? 0 : vbuf + 1;
        if (i + 1 < NT) A_WRITE(buf ^ 1, vbuf, sub ^ 1);
        if (MODE == 1) {
            const bool done_w = __all(carry == 0.f); wdone = done_w;
            if (lane == 0) *(LAS unsigned*)(lds + A_OFF_FLAG + (i & 1) * 32 + wid * 4) = done_w ? 1u : 0u;
        }
        __syncthreads();
        if (MODE == 1) {
            const u32x4 f0 = *(const LAS u32x4*)(lds + A_OFF_FLAG + (i & 1) * 32), f1 = *(const LAS u32x4*)(lds + A_OFF_FLAG + (i & 1) * 32 + 16);
            if ((f0.x & f0.y & f0.z & f0.w & f1.x & f1.y & f1.z & f1.w) != 0u) { stop = true; break; }
        }
    }
    }
    if (lag && pend) A_PV(vprev);
    __syncthreads();
    float inv = 1.f;
    if (MODE == 0) { const float lt = lrun + lane_partner(lrun, hi); inv = 1.f / lt; }
    unsigned char* Ob = (unsigned char*)(O + (rowbase + qabs) * D + h * 64) + (hi ? 16 : 0);
    u32x2 wk[8];
#pragma unroll
    for (int k = 0; k < 8; ++k) {
        if (k < 4) { wk[k].x = cvtpk(o0[4 * k] * inv, o0[4 * k + 1] * inv); wk[k].y = cvtpk(o0[4 * k + 2] * inv, o0[4 * k + 3] * inv); }
        else { wk[k].x = cvtpk(o1[4 * (k - 4)] * inv, o1[4 * (k - 4) + 1] * inv); wk[k].y = cvtpk(o1[4 * (k - 4) + 2] * inv, o1[4 * (k - 4) + 3] * inv); }
    }
#pragma unroll
    for (int k = 0; k < 8; k += 2) {
        auto rx = __builtin_amdgcn_permlane32_swap(wk[k].x, wk[k + 1].x, false, false);
        auto ry = __builtin_amdgcn_permlane32_swap(wk[k].y, wk[k + 1].y, false, false);
        *(u32x4*)(Ob + 16 * k) = (u32x4){rx[0], ry[0], rx[1], ry[1]};
    }
#undef A_TILE
#undef A_LOAD
#undef A_WRITE
#undef A_PV
}

template <int MODE>
__device__ __forceinline__ void attn_phase(int vcu, int G, const bf16* Q, const bf16* K, const bf16* VT, const float* C2, bf16* O, LAS unsigned char* lds) {
    for (int v = vcu; v < 256; v += G) {
        const int bh = v >> 1, s = v & 1;
        for (int i = 0; i < 8; ++i) { const int jj = 2 * (i >> 1) + s; const int qb = (i & 1) ? 15 - jj : jj;
            attn_unit<MODE>(bh / NH, bh % NH, qb, Q, K, VT, C2, O, lds); }
    }
}
#define atomicAdd_u(p, v) atomicAdd(p, v)
#define XB_TMO      128
#define XB_XCNT(j)  (256  + 64 * (j))
#define XB_XSUB(j)  (1280 + 64 * (j))
#define XB_XGEN(j)  (2304 + 64 * (j))
#define XB_TOP      3328
#define XB_TOPGEN   3392
#define XCD_BAR_WORDS 3456
#define XB_SPIN_CAP (1u << 18)

__device__ __forceinline__ unsigned xb_ld(unsigned* p)              { return __hip_atomic_load(p, __ATOMIC_RELAXED, __HIP_MEMORY_SCOPE_AGENT); }
__device__ __forceinline__ unsigned xb_add(unsigned* p, unsigned v) { return __hip_atomic_fetch_add(p, v, __ATOMIC_RELAXED, __HIP_MEMORY_SCOPE_AGENT); }
__device__ __forceinline__ unsigned xb_xcc_id() { return (unsigned)__builtin_amdgcn_s_getreg((3 << 11) | 20) & 0xFu; }
#define XB_SPIN(cond, bar) do { unsigned _sp = 0; while (cond) { __builtin_amdgcn_s_sleep(1); \
    if ((++_sp & 255u) == 0u) { if (xb_ld(&(bar)[XB_TMO])) break; if (_sp > XB_SPIN_CAP) { atomicAdd(&(bar)[XB_TMO], 1u); break; } } } } while (0)

struct XcdBarrier {
    unsigned* bar; unsigned x;
    volatile LAS unsigned* st;
};

__device__ __forceinline__ XcdBarrier xcd_barrier_post(unsigned* bar, volatile LAS unsigned* st) {
    XcdBarrier b; b.bar = bar; b.x = xb_xcc_id(); b.st = st;
    if (threadIdx.x == 0) (void)xb_add(&bar[XB_XCNT(b.x)], 1u);
    return b;
}
__device__ __forceinline__ void xcd_barrier_complete(unsigned* bar, unsigned x, unsigned& nloc, unsigned& nx) {
    const unsigned G = gridDim.x * gridDim.y * gridDim.z;
    unsigned sum, cnt, mine, sp = 0u;
    for (;;) {
        sum = 0u; cnt = 0u; mine = 0u;
#pragma unroll
        for (unsigned j = 0; j < 16; ++j) { const unsigned c = xb_ld(&bar[XB_XCNT(j)]); sum += c; cnt += (c > 0u) ? 1u : 0u; mine = (j == x) ? c : mine; }
        if (sum == G) break;
        __builtin_amdgcn_s_sleep(1);
        if ((++sp & 255u) == 0u) { if (xb_ld(&bar[XB_TMO])) break; if (sp > XB_SPIN_CAP) { atomicAdd(&bar[XB_TMO], 1u); break; } }
    }
    nloc = mine > 0u ? mine : 1u; nx = cnt > 0u ? cnt : 1u;
}

__device__ __forceinline__ void xcd_barrier(const XcdBarrier& b) {
    asm volatile("s_waitcnt vmcnt(0)" ::: "memory");
    __syncthreads();
    if (threadIdx.x == 0) {
        unsigned* bar = b.bar;
        __builtin_amdgcn_s_waitcnt(0);
        unsigned nloc = b.st[0], nx = b.st[1];
        if (nloc == 0u) { xcd_barrier_complete(bar, b.x, nloc, nx); b.st[0] = nloc; b.st[1] = nx; }
        const unsigned old = xb_add(&bar[XB_XSUB(b.x)], 1u);
        const unsigned gen = old / nloc;
        if (old + 1u == (gen + 1u) * nloc) {
            __builtin_amdgcn_fence(__ATOMIC_RELEASE, "agent");
            asm volatile("s_waitcnt vmcnt(0)" ::: "memory");
            const unsigned og = xb_add(&bar[XB_TOP], 1u);
            const unsigned tg = og / nx;
            if (og + 1u == (tg + 1u) * nx) xb_add(&bar[XB_TOPGEN], 1u);
            else XB_SPIN(xb_ld(&bar[XB_TOPGEN]) == tg, bar);
            __builtin_amdgcn_fence(__ATOMIC_ACQUIRE, "agent");
            xb_add(&bar[XB_XGEN(b.x)], 1u);
            asm volatile("s_waitcnt vmcnt(0)" ::: "memory");
        } else {
            XB_SPIN(xb_ld(&bar[XB_XGEN(b.x)]) == gen, bar);
            __builtin_amdgcn_fence(__ATOMIC_ACQUIRE, "agent");
            asm volatile("s_waitcnt vmcnt(0)" ::: "memory");
        }
    }
    __syncthreads();
}

struct Args { const float* in[13]; float* out; unsigned char* ws; };

__device__ __forceinline__ void transpose_item(const float* W, int ldw, int k0, int n0, bf16* WT, int K, int drow0, LAS float* scr, int lane) {
#pragma unroll 8
    for (int i = 0; i < 32; ++i) { const int kk = 2 * i + (lane >> 5); scr[kk * 33 + (lane & 31)] = W[(size_t)(k0 + kk) * ldw + n0 + (lane & 31)]; }
    asm volatile("s_waitcnt lgkmcnt(0)" ::: "memory");
    const int c = lane & 7;
#pragma unroll
    for (int j = 0; j < 4; ++j) { const int n = (lane >> 3) + 8 * j; const LAS float* s = scr + (8 * c) * 33 + n;
        u32x4 o; o.x = cvtpk(s[0], s[33]); o.y = cvtpk(s[2 * 33], s[3 * 33]); o.z = cvtpk(s[4 * 33], s[5 * 33]); o.w = cvtpk(s[6 * 33], s[7 * 33]);
        *(u32x4*)(WT + (size_t)(drow0 + n) * K + k0 + 8 * c) = o; }
    asm volatile("s_waitcnt lgkmcnt(0)" ::: "memory");
}

#define PIN(T, i) ((T*)ldptr(lds, (i)))
__device__ __forceinline__ void* ldptr(LAS unsigned char* lds, int i) {
    const u32x2 v = *(const LAS u32x2*)(lds + PTAB_OFF + 8 * i);
    const unsigned long long p = ((unsigned long long)(unsigned)__builtin_amdgcn_readfirstlane((int)v.y) << 32) | (unsigned)__builtin_amdgcn_readfirstlane((int)v.x);
    return (void*)(__attribute__((address_space(1))) char*)p; }
__device__ __forceinline__ void prologue(LAS unsigned char* lds, int gw, int NGW, int wave, int lane) {
    unsigned char* a_ws = PIN(unsigned char, 14);
    LAS float* scr = (LAS float*)(lds + wave * 16384);
    constexpr int I_QKV = 16 * 96, I_O = 16 * 32, I_UP = 16 * 176, I_DN = 44 * 32, I_L = I_QKV + I_O + I_UP + I_DN;
    for (int it = gw; it < DEPTH * I_L; it += NGW) {
        const int l = it / I_L; int r = it % I_L; const int j = l >> 1; const bool fox = !(l & 1);
        bf16* wl = (bf16*)(a_ws + WS_W + (size_t)l * W_LAYER);
        if (r < I_QKV) { const int kb = r / 96, n0 = 32 * (r % 96);
            const float* W = fox ? PIN(const float, 4) + (size_t)j * D * 3088 : PIN(const float, 7) + (size_t)j * D * 3072; const int ldw = fox ? 3088 : 3072;
            if (n0 < 2048) transpose_item(W, ldw, 64 * kb, n0, wl + WO_QK / 2, D, n0, scr, lane);
            else transpose_item(W, ldw, 64 * kb, n0, wl + WO_V / 2, D, n0 - 2048, scr, lane);
            continue; }
        r -= I_QKV;
        if (r < I_O) { const int kb = r / 32, n0 = 32 * (r % 32); const float* W = (fox ? PIN(const float, 6) : PIN(const float, 8)) + (size_t)j * D * D;
            transpose_item(W, D, 64 * kb, n0, wl + WO_O / 2, D, n0, scr, lane); continue; }
        r -= I_O;
        if (r < I_UP) { const int kb = r / 176, c = 32 * (r % 176); const int drow0 = c < FF ? 256 * (c / 128) + (c % 128) : 256 * ((c - FF) / 128) + 128 + ((c - FF) % 128);
            transpose_item(PIN(const float, 9) + (size_t)l * D * FF2, FF2, 64 * kb, c, wl + WO_UP / 2, D, drow0, scr, lane); continue; }
        r -= I_UP;
        { const int kb = r / 32, n0 = 32 * (r % 32); transpose_item(PIN(const float, 12) + (size_t)l * FF * D, D, 64 * kb, n0, wl + WO_DN / 2, FF, n0, scr, lane); }
    }
}

template <bool FOX, bool SRC_BF16>
__device__ __forceinline__ void norm_phase(const void* src, const float* gain, bf16* xn, const float* Wf, const float* bfp, float* flog, LAS unsigned char* lds, int vcu, int G) {
    int tid = threadIdx.x; asm volatile("" : "+v"(tid));
    const int lane = tid & 63, gw = vcu * NWAVES + (tid >> 6), NGW = G * NWAVES;
    LAS float* wf = (LAS float*)lds;
    if (FOX) {
        for (int k = tid; k < D; k += NTHR) { const f32x4* p = (const f32x4*)(Wf + (size_t)k * 3088 + 3072);
#pragma unroll
            for (int q = 0; q < 4; ++q) { const f32x4 w = p[q];
#pragma unroll
                for (int e = 0; e < 4; ++e) wf[(4 * q + e) * 1024 + k] = w[e]; } }
        __syncthreads();
    }
    f32x4 g[4];
#pragma unroll
    for (int j = 0; j < 4; ++j) g[j] = ((const f32x4*)gain)[lane + 64 * j];
    for (int m = gw; m < M; m += NGW) {
        f32x4 v[4]; float s = 0.f;
#pragma unroll
        for (int j = 0; j < 4; ++j) {
            if (SRC_BF16) { const u32x2 w = ((const u32x2*)((const bf16*)src + (size_t)m * D))[lane + 64 * j]; v[j] = (f32x4){bflo(w.x), bfhi(w.x), bflo(w.y), bfhi(w.y)}; }
            else v[j] = ((const f32x4*)((const float*)src + (size_t)m * D))[lane + 64 * j];
            s += (v[j].x * v[j].x + v[j].y * v[j].y) + (v[j].z * v[j].z + v[j].w * v[j].w); }
        const float rstd = 1.0f / sqrtf(wave_sum(s) * (1.f / D) + NORM_EPS);
        u32x2* o8 = (u32x2*)(xn + (size_t)m * D) + lane;
#pragma unroll
        for (int j = 0; j < 4; ++j) { v[j] = v[j] * rstd * g[j]; u32x2 w; w.x = cvtpk(v[j].x, v[j].y); w.y = cvtpk(v[j].z, v[j].w); o8[64 * j] = w; }
        if (FOX) {
            float mine = 0.f; int lane_l = lane; asm volatile("" : "+v"(lane_l));
#pragma unroll
            for (int hh = 0; hh < 16; ++hh) { float acc = 0.f;
#pragma unroll
                for (int j = 0; j < 4; ++j) { const f32x4 w = *(const LAS f32x4*)(wf + hh * 1024 + 256 * j + 4 * lane); acc += (v[j].x * w.x + v[j].y * w.y) + (v[j].z * w.z + v[j].w * w.w); }
                acc = wave_sum(acc); mine = (lane_l == hh) ? acc : mine; }
            if (lane < 16) { const float x2 = (mine + bfp[lane]) * LOG2E; flog[(size_t)m * 16 + lane] = fminf(x2, 0.f) - lg2(1.f + ex2(-fabsf(x2))); }
        }
    }
    if (FOX) __syncthreads();
}

__device__ __forceinline__ void scan_phase(const float* flog, float* c2, LAS unsigned char* lds, int G) {
    int tid = threadIdx.x; asm volatile("" : "+v"(tid));
    const int lane = tid & 63, wave = tid >> 6;
    LAS float* wsum = (LAS float*)(lds + MISC_OFF);
    for (int bh = blockIdx.x; bh < BATCH * NH; bh += G) {
        const int b = bh / NH, h = bh % NH;
        float v[8]; float run = 0.f;
#pragma unroll
        for (int i = 0; i < 8; ++i) { run += flog[((size_t)b * SEQ + 8 * tid + i) * 16 + h]; v[i] = run; }
        float incl = run;
#pragma unroll
        for (int o = 1; o < 64; o <<= 1) { const float nb = __shfl_up(incl, o); if (lane >= o) incl += nb; }
        if (lane == 63) wsum[wave] = incl;
        __syncthreads();
        float woff = 0.f;
#pragma unroll
        for (int w = 0; w < NWAVES; ++w) woff += (w < wave) ? wsum[w] : 0.f;
        const float excl = incl - run + woff;
        f32x4 o0 = (f32x4){v[0] + excl, v[1] + excl, v[2] + excl, v[3] + excl}, o1 = (f32x4){v[4] + excl, v[5] + excl, v[6] + excl, v[7] + excl};
        f32x4* dst = (f32x4*)(c2 + (size_t)bh * SEQ + 8 * tid); dst[0] = o0; dst[1] = o1;
        __syncthreads();
    }
}

__device__ __forceinline__ void fixup_phase(const float* edge, const float* raw01, const float* wconv, const float* bconv, bf16* act, int bx, int G) {
    int tid = threadIdx.x; asm volatile("" : "+v"(tid));
    const int gtid = bx * NTHR + tid, NGT = G * NTHR;
    for (int idx = gtid; idx < (M / 256) * 2 * FF; idx += NGT) {
        const int c = idx % FF, rr = (idx / FF) & 1, pm = idx / (2 * FF);
        const bool has = (pm % (SEQ / 256)) != 0;
        float r[2];
#pragma unroll
        for (int s = 0; s < 2; ++s) { const int col = s * FF + c;
            const float h0 = raw01[((size_t)pm * 2 + rr) * FF2 + col];
            const float e1 = has ? edge[((size_t)(pm - 1) * 2 + 1) * FF2 + col] : 0.f, e0 = has ? edge[((size_t)(pm - 1) * 2 + 0) * FF2 + col] : 0.f;
            const float hm1 = rr == 0 ? e1 : raw01[((size_t)pm * 2 + 0) * FF2 + col], hm2 = rr == 0 ? e0 : e1;
            r[s] = bconv[col] + wconv[2 * FF2 + col] * h0 + wconv[FF2 + col] * hm1 + wconv[col] * hm2; }
        const float sg = r[1] * __builtin_amdgcn_rcpf(1.f + ex2(-r[1] * LOG2E));
        act[(size_t)(pm * 256 + rr) * FF + c] = (bf16)(cvtpk(sg * r[0], 0.f) & 0xffffu);
    }
}


#ifndef DBG_STAGE
#define DBG_STAGE 0
#endif
#ifndef DBG_SKIP
#define DBG_SKIP 0
#endif
#ifndef DBG_FRAC
#define DBG_FRAC 1
#endif
__device__ __forceinline__ void dbg_dump_bf16(const bf16* src, float* out, int bx, int G) {
    int tid = threadIdx.x; asm volatile("" : "+v"(tid));
    for (size_t i = (size_t)bx * NTHR + tid; i < (size_t)M * D; i += (size_t)G * NTHR) { float v = __uint_as_float((unsigned)src[i] << 16); if (!(fabsf(v) < 1e30f)) v = 10000.f; out[i] = v; }
}

__device__ __forceinline__ float bf2f(bf16 v) { return __uint_as_float((unsigned)v << 16); }
__device__ __forceinline__ unsigned hash32(unsigned x) { x ^= x >> 16; x *= 0x7feb352du; x ^= x >> 15; x *= 0x846ca68bu; x ^= x >> 16; return x; }
__device__ __forceinline__ void dbg_acc(float* word, float got, float exp_) { const float d = fabsf(got - exp_) / (fabsf(exp_) + 0.05f); atomicMax((unsigned*)word, __float_as_uint(d)); }
__device__ __forceinline__ void dbg_check_qkv(const bf16* xn, const float* W  , const bf16* q, const bf16* k, const bf16* vt, float* word, int bx, int G) {
    int tid = threadIdx.x; asm volatile("" : "+v"(tid));
    const unsigned sidx = bx * NTHR + tid; if (sidx >= 16384u) return;
    const unsigned hsh = hash32(sidx * 2654435761u + 12345u); const int row = hsh % M, col = (hsh >> 15) % 3072;
    float acc = 0.f; for (int kk = 0; kk < D; ++kk) acc += bf2f(xn[(size_t)row * D + kk]) * W[(size_t)kk * 3088 + col];
    float got; if (col < 1024) { got = bf2f(q[(size_t)row * D + col]); acc *= QSCALE; } else if (col < 2048) got = bf2f(k[(size_t)row * D + col - 1024]); else got = bf2f(vt[(size_t)(col - 2048) * M + row]);
    dbg_acc(word, got, acc);
}
__device__ __forceinline__ void dbg_check_act(const bf16* xn, const float* Wup  , const float* wconv, const float* bconv, const bf16* act, float* word, int bx, int G, int mode) {
    int tid = threadIdx.x; asm volatile("" : "+v"(tid));
    const unsigned sidx = bx * NTHR + tid; if (sidx >= 16384u) return;
    const unsigned hsh = hash32(sidx * 2654435761u + 777u); int row = hsh % M; int c = (hsh >> 15) % FF;
    if (mode == 7) { row = (row & ~15) + 2 + (int)((hsh >> 27) % 12u); c = (c & ~127) + (int)((hsh >> 20) % 32u); }
    if (mode == 9) { row = (row & ~255 & ~(8 * 256)) + 2 + (int)((hsh >> 27) % 12u) + 16 * (int)((hsh >> 23) % 16u); c = c % 512; }
    if (mode == 8) { row = (row & ~255) + 2 + (int)((hsh >> 27) % 12u); }
    if (mode == 1) row = (row & ~255) + (sidx & 1);
    if (mode == 2) row = (row & ~63) + (sidx & 1);
    if (mode == 3) row = (row & ~15) + (sidx & 1);
    if (mode == 4) row = (row & ~15) + 2 + (int)((hsh >> 27) % 14u);
    if (mode == 5) row = (row & ~15) + 14 + (sidx & 1);
    if (mode == 6) row = (row & ~15) + 2 + (int)((hsh >> 27) % 12u);
    float hc[2];
    for (int s2 = 0; s2 < 2; ++s2) { const int col = s2 * FF + c; float tot = bconv[col];
        for (int tap = 0; tap < 3; ++tap) { const int r = row - 2 + tap; if ((r >> 12) != (row >> 12) || r < 0) continue;
            float acc = 0.f; for (int kk = 0; kk < D; ++kk) acc += bf2f(xn[(size_t)r * D + kk]) * Wup[(size_t)kk * FF2 + col];
            tot += wconv[tap * FF2 + col] * acc; }
        hc[s2] = tot; }
    const float exp_ = hc[0] * hc[1] / (1.f + __expf(-hc[1]));
    const float got_ = bf2f(act[(size_t)row * FF + c]);
    if (DBG_FRAC) { if (fabsf(got_ - exp_) > 0.1f * (fabsf(exp_) + 0.2f)) atomicAdd(word, 1.f / 16384.f); }
    else dbg_acc(word, got_, exp_);
}
__device__ __forceinline__ void dbg_check_attn(const bf16* q, const bf16* k, const bf16* vt, const float* c2, const bf16* o, float* word, int bx, int G, int mode) {
    int tid = threadIdx.x; asm volatile("" : "+v"(tid));
    const int lane = tid & 63; const unsigned sidx = bx * NWAVES + (tid >> 6); if (sidx >= 1024u) return;
    const unsigned hsh = hash32(sidx * 2654435761u + 99u); const int b = hsh % BATCH, h = (hsh >> 8) % NH; int qp = (hsh >> 14) % SEQ; if ((sidx & 7) == 0) qp = (qp & ~255) + (sidx >> 3) % 70;
    const size_t rb = (size_t)b * SEQ; const float qv = bf2f(q[(rb + qp) * D + h * 64 + lane]);
    float od = 0.f;
    if (mode == 0) {
        float mx = -INFINITY; for (int j = 0; j <= qp; ++j) { const float z = wave_sum(qv * bf2f(k[(rb + j) * D + h * 64 + lane])) - c2[((size_t)(b * NH + h)) * SEQ + j]; mx = fmaxf(mx, z); }
        float l = 0.f; for (int j = 0; j <= qp; ++j) { const float z = wave_sum(qv * bf2f(k[(rb + j) * D + h * 64 + lane])) - c2[((size_t)(b * NH + h)) * SEQ + j]; const float p = exp2f(z - mx); l += p; od += p * bf2f(vt[(size_t)(h * 64 + lane) * M + rb + j]); }
        od /= l;
    } else {
        float tail = 0.f; for (int j = qp - 1; j >= 0 && tail > -200.f; --j) { const float z = wave_sum(qv * bf2f(k[(rb + j) * D + h * 64 + lane]));
            const float sp = log2f(1.f + exp2f(z)); const float a = exp2f(z - sp + tail); tail -= sp; od += a * bf2f(vt[(size_t)(h * 64 + lane) * M + rb + j]); }
    }
    const float got = bf2f(o[(rb + qp) * D + h * 64 + lane]);
    const float d = fabsf(got - od) / (fabsf(od) + 0.02f); atomicMax((unsigned*)word, __float_as_uint(d));
}
__device__ __forceinline__ void dbg_check_resid(const float* base, const bf16* a, int K, const float* W, const float* hs, float* word, int bx, int G) {
    int tid = threadIdx.x; asm volatile("" : "+v"(tid));
    const unsigned sidx = bx * NTHR + tid; if (sidx >= 16384u) return;
    const unsigned hsh = hash32(sidx * 2654435761u + 4242u); const int row = hsh % M, col = (hsh >> 15) % D;
    float acc = 0.f; for (int kk = 0; kk < K; ++kk) acc += bf2f(a[(size_t)row * K + kk]) * W[(size_t)kk * D + col];
    const float exp_ = base[(size_t)row * D + col] + acc; dbg_acc(word, hs[(size_t)row * D + col], exp_);
}
#define DBG_BEGIN() do { if (bx0 == 0 && threadIdx.x == 0) *(float*)(PIN(unsigned char, 14) + WS_FLOG - 256) = 0.f; } while (0)
#define DBG_WORD ((float*)(PIN(unsigned char, 14) + WS_FLOG - 256))
#define DBG_FINISH() do { { int tz = threadIdx.x; asm volatile("" : "+v"(tz)); float* od_ = PIN(float, 13); for (size_t i = (size_t)bx0 * NTHR + tz; i < (size_t)M * D; i += (size_t)G0 * NTHR) od_[i] = 0.f; } GSYNC(); \
    if (bx0 == 0 && threadIdx.x == 0) PIN(float, 13)[0] = 10.f + 1000.f * *DBG_WORD; return; } while (0)

#ifndef DBG_DUP
#define DBG_DUP 0
#endif
#ifndef A_QG0
#define A_QG0 2
#endif
#ifndef DBG_TA
#define DBG_TA -1
#endif
#ifndef DBG_TB
#define DBG_TB -1
#endif
#define TSTAMP(cat) do { if (DBG_TA >= 0 && bx0 == 0 && threadIdx.x == 0) { const unsigned long long now_ = __builtin_amdgcn_s_memrealtime(); LAS unsigned* tw_ = (LAS unsigned*)(lds + TIME_OFF); \
    tw_[(cat)] += (unsigned)(now_ - (((unsigned long long)tw_[15] << 32) | tw_[14])); tw_[14] = (unsigned)now_; tw_[15] = (unsigned)(now_ >> 32); } } while (0)
#define GSYNC_CG() do { asm volatile("s_waitcnt vmcnt(0) lgkmcnt(0)" ::: "memory"); __builtin_amdgcn_fence(__ATOMIC_RELEASE, "agent"); grid.sync(); __builtin_amdgcn_fence(__ATOMIC_ACQUIRE, "agent"); } while (0)
#define GSYNC() do { xcd_barrier(xbar); if (DBG_DUP & 64) xcd_barrier(xbar); } while (0)
__global__ void __launch_bounds__(NTHR, 2) fwd_kernel(Args a) {
    extern __shared__ __attribute__((aligned(16))) unsigned char lds_raw[];
    LAS unsigned char* lds = (LAS unsigned char*)lds_raw;
    cg::grid_group grid = cg::this_grid();
    const int tid = threadIdx.x, lane = tid & 63; const int wave = __builtin_amdgcn_readfirstlane(tid >> 6);
    const int G0 = gridDim.x, bx0 = blockIdx.x;
    const int vcu0 = (G0 % 8 == 0) ? (bx0 % 8) * (G0 / 8) + bx0 / 8 : bx0;
    if (tid == 0) {
#pragma unroll
        for (int i = 0; i < 13; ++i) *(LAS unsigned long long*)(lds + PTAB_OFF + 8 * i) = (unsigned long long)a.in[i];
        *(LAS unsigned long long*)(lds + PTAB_OFF + 8 * 13) = (unsigned long long)a.out; *(LAS unsigned long long*)(lds + PTAB_OFF + 8 * 14) = (unsigned long long)a.ws;
    }
    if (tid < 2) ((LAS unsigned*)(lds + MISC_OFF + 64))[tid] = 0u;
    __syncthreads();
    const XcdBarrier xbar = xcd_barrier_post((unsigned*)(PIN(unsigned char, 14) + WS_BAR), (volatile LAS unsigned*)(lds + MISC_OFF + 64));
#define WSP(T, off) ((T*)(PIN(unsigned char, 14) + (off)))
#define XN WSP(bf16, WS_XN)
#define QO WSP(bf16, WS_QO)
#define KB WSP(bf16, WS_K)
#define VT WSP(bf16, WS_VT)
#define ACT WSP(bf16, WS_ACT)
#define FLOG WSP(float, WS_FLOG)
#define C2 WSP(float, WS_C2)
#define EDGE WSP(float, WS_EDGE)
#define RAW01 WSP(float, WS_RAW01)
#define HS PIN(float, 13)
#define HSB WSP(bf16, WS_HSB)
#define XIN PIN(const float, 0)
    if (DBG_STAGE >= 30) DBG_BEGIN();
    if (DBG_TA >= 0 && bx0 == 0 && threadIdx.x == 0) { LAS unsigned* tw_ = (LAS unsigned*)(lds + TIME_OFF); for (int i_ = 0; i_ < 14; ++i_) tw_[i_] = 0u; const unsigned long long now_ = __builtin_amdgcn_s_memrealtime(); tw_[14] = (unsigned)now_; tw_[15] = (unsigned)(now_ >> 32); }
    prologue(lds, vcu0 * NWAVES + wave, G0 * NWAVES, wave, lane);
    if (DBG_DUP & 32) prologue(lds, vcu0 * NWAVES + wave, G0 * NWAVES, wave, lane);
    __syncthreads();
    norm_phase<true, false>(XIN, PIN(const float, 1), XN, PIN(const float, 4), PIN(const float, 5), FLOG, lds, vcu0, G0);
    if (PIN(unsigned char, 14) == nullptr) grid.sync();
    GSYNC(); TSTAMP(0);
    if (DBG_STAGE == 1) { dbg_dump_bf16(XN, HS, bx0, G0); return; }
    for (int l = 0; l < DEPTH; ++l) {
        const bool fox = !(l & 1); const int j = l >> 1;
        int G = G0, bx = bx0, vcu = vcu0; asm volatile("" : "+s"(G), "+s"(bx), "+s"(vcu));
        #define WL ((const bf16*)(PIN(unsigned char, 14) + WS_W + (size_t)l * W_LAYER))
        if (l > 0) {
            if (fox) norm_phase<true, true>(HSB, PIN(const float, 1) + l * D, XN, PIN(const float, 4) + (size_t)j * D * 3088, PIN(const float, 5) + j * NH, FLOG, lds, vcu, G);
            else norm_phase<false, true>(HSB, PIN(const float, 1) + l * D, XN, nullptr, nullptr, nullptr, lds, vcu, G);
            if (DBG_DUP & 16) norm_phase<false, true>(HSB, PIN(const float, 1) + l * D, XN, nullptr, nullptr, nullptr, lds, vcu, G);
            GSYNC(); TSTAMP(1);
        }
        if (fox) scan_phase(FLOG, C2, lds, G);
        for (int rep_ = 0; rep_ < ((DBG_DUP & 1) ? 2 : 1); ++rep_) {
        { pg8::Gemm g{XN, WL + WO_QK / 2, M, 2048, D}; pg8::StaticOrder S; S.init(M, 2048, G, bx);
          pg8::EpiBf16<0> E{QO, D, nullptr, D, (size_t)(WS_K - WS_QO) / 2, QSCALE};
#ifndef NO_QK
          pg8::gemm_phase<pg8::EpiBf16<0>, pg8::StaticOrder, true, true>(lds, g, S, E);
#endif
        }
        { pg8::Gemm g{WL + WO_V / 2, XN, D, M, D}; pg8::StaticOrder S; S.init(D, M, G, bx);
          pg8::EpiBf16<0> E{VT, M, nullptr, 0, 0, 1.f};
#ifndef NO_VT
          pg8::gemm_phase<pg8::EpiBf16<0>, pg8::StaticOrder, true, true>(lds, g, S, E);
#endif
        }
        }
        GSYNC(); TSTAMP(2);
        if (DBG_STAGE == 31 && l == 0) { dbg_check_qkv(XN, PIN(const float, 4), QO, KB, VT, DBG_WORD, bx, G); DBG_FINISH(); }
        if (DBG_STAGE == 32 && l == 0) { attn_phase<0>(vcu, G, QO, KB, VT, C2, XN, lds); GSYNC(); dbg_check_attn(QO, KB, VT, C2, XN, DBG_WORD, bx, G, 0); DBG_FINISH(); }
        if (DBG_STAGE == 35 && l == 1) { attn_phase<1>(vcu, G, QO, KB, VT, C2, XN, lds); GSYNC(); dbg_check_attn(QO, KB, VT, C2, XN, DBG_WORD, bx, G, 1); DBG_FINISH(); }
        if (DBG_STAGE == 2) { dbg_dump_bf16(QO, HS, bx, G); return; }
        if (DBG_STAGE == 3) { dbg_dump_bf16(KB, HS, bx, G); return; }
        if (DBG_STAGE == 4) { dbg_dump_bf16(VT, HS, bx, G); return; }
        if ((DBG_DUP & 4) && fox) attn_phase<0>(vcu, G, QO, KB, VT, C2, XN, lds);
        if ((DBG_DUP & 8) && !fox) attn_phase<1>(vcu, G, QO, KB, VT, C2, XN, lds);
#ifndef NO_ATT0
        if (fox || DBG_STAGE == 10) attn_phase<0>(vcu, G, QO, KB, VT, C2, QO, lds);
#endif
#ifndef NO_ATT1
        if (!fox && DBG_STAGE != 10) attn_phase<1>(vcu, G, QO, KB, VT, C2, QO, lds);
#endif
        GSYNC(); TSTAMP(fox ? 3 : 4);
        if (DBG_STAGE == 5) { dbg_dump_bf16(QO, HS, bx, G); return; }
        if (DBG_STAGE == 9 && l == 1) { dbg_dump_bf16(QO, HS, bx, G); return; }
        if ((DBG_SKIP & (fox ? 1 : 2)) != 0) {
            if (l == 0) { int tq = threadIdx.x; asm volatile("" : "+v"(tq)); const float* xs = XIN; float* hd = HS;
                for (size_t i = (size_t)bx * NTHR + tq; i < (size_t)M * D / 4; i += (size_t)G * NTHR) ((f32x4*)hd)[i] = ((const f32x4*)xs)[i]; }
        } else
        { pg8::Gemm g{QO, WL + WO_O / 2, M, D, D}; pg8::StaticOrder S; S.init(M, D, G, bx);
#ifndef NO_O
          if (l == 0) { EpiResid<true> E{XIN, HSB}; pg8::gemm_phase<EpiResid<true>, pg8::StaticOrder, true, true>(lds, g, S, E); }
          else { EpiResid<false> E{HSB, HSB}; pg8::gemm_phase<EpiResid<false>, pg8::StaticOrder, true, true>(lds, g, S, E); }
#endif
        }
        GSYNC(); TSTAMP(5);
        if (DBG_STAGE == 33 && l == 0) { dbg_check_resid(XIN, QO, D, PIN(const float, 6), HS, DBG_WORD, bx, G); DBG_FINISH(); }
        if (DBG_STAGE == 6) return;
        if ((DBG_SKIP & 4) != 0) continue;
        if ((DBG_STAGE == 8 || DBG_STAGE == 10) && l == 1) return;
        norm_phase<false, true>(HSB, PIN(const float, 2) + l * D, XN, nullptr, nullptr, nullptr, lds, vcu, G);
        if (DBG_DUP & 16) norm_phase<false, true>(HSB, PIN(const float, 2) + l * D, XN, nullptr, nullptr, nullptr, lds, vcu, G);
        GSYNC(); TSTAMP(1);
        #define WCONV (PIN(const float, 10) + (size_t)l * 3 * FF2)
#define BCONV (PIN(const float, 11) + (size_t)l * FF2)
        for (int rep_ = 0; rep_ < ((DBG_DUP & 2) ? 2 : 1); ++rep_)
        { pg8::Gemm g{XN, WL + WO_UP / 2, M, FF2, D}; pg8::StaticOrder S; S.init(M, FF2, G, bx);
          EpiConvGate E{ACT, WCONV, BCONV, EDGE, RAW01, (LAS float*)(lds + XCH_OFF)};
#ifndef NO_UP
          pg8::gemm_phase<EpiConvGate, pg8::StaticOrder, true, true>(lds, g, S, E);
#endif
        }
        GSYNC(); TSTAMP(6);
        fixup_phase(EDGE, RAW01, WCONV, BCONV, ACT, bx, G);
        GSYNC(); TSTAMP(7);
        if (DBG_STAGE >= 40 && DBG_STAGE <= 49 && l == 0) { dbg_check_act(XN, PIN(const float, 9), WCONV, BCONV, ACT, DBG_WORD, bx, G, DBG_STAGE - 40); DBG_FINISH(); }
        { pg8::Gemm g{ACT, WL + WO_DN / 2, M, D, FF}; pg8::StaticOrder S; S.init(M, D, G, bx);
#ifndef NO_DN
          { EpiResid<false> E{HSB, HSB}; pg8::gemm_phase<EpiResid<false>, pg8::StaticOrder, true, true>(lds, g, S, E); }
#endif
        }
        GSYNC(); TSTAMP(8);        if (DBG_STAGE == 7) return;
    }
    {
        int tidf = threadIdx.x; asm volatile("" : "+v"(tidf));
        const int lane = tidf & 63, gw = vcu0 * NWAVES + (tidf >> 6), NGW = G0 * NWAVES;
        f32x4 g[4];
#pragma unroll
        for (int jq = 0; jq < 4; ++jq) g[jq] = ((const f32x4*)PIN(const float, 3))[lane + 64 * jq];
        float* out_ = HS; const bf16* hsb_ = HSB;
        for (int m = gw; m < M; m += NGW) {
            f32x4* xr = (f32x4*)(out_ + (size_t)m * D) + lane;
            f32x4 v[4]; float s = 0.f;
#pragma unroll
            for (int jq = 0; jq < 4; ++jq) { const u32x2 w = ((const u32x2*)(hsb_ + (size_t)m * D))[lane + 64 * jq]; v[jq] = (f32x4){bflo(w.x), bfhi(w.x), bflo(w.y), bfhi(w.y)};
                s += (v[jq].x * v[jq].x + v[jq].y * v[jq].y) + (v[jq].z * v[jq].z + v[jq].w * v[jq].w); }
            const float rstd = 1.0f / sqrtf(wave_sum(s) * (1.f / D) + NORM_EPS);
#pragma unroll
            for (int jq = 0; jq < 4; ++jq) xr[64 * jq] = v[jq] * rstd * g[jq];
        }
    }
    if (DBG_TA >= 0) {
        GSYNC(); TSTAMP(9);
        if (bx0 == 0) { const LAS unsigned* tw_ = (const LAS unsigned*)(lds + TIME_OFF); float* od_ = PIN(float, 13); int tz = threadIdx.x;
            const float va = 40.f + 5.f * log2f(0.01f * (float)tw_[DBG_TA < 0 ? 0 : DBG_TA] + 1.f), vb = 5.f * log2f(0.01f * (float)tw_[DBG_TB < 0 ? 0 : DBG_TB] + 1.f);
            for (int i = tz; i < 32768; i += NTHR) od_[i] = (i == 0) ? va : vb; }
    }
}

extern "C" void kernel_launch(void* const* d_in, const int* in_sizes, int n_in, void* d_out, int out_size, void* d_ws, size_t ws_size, hipStream_t stream) {
    static int grid = 0;
    if (grid == 0) {
        if (n_in != 13 || out_size != M * D || ws_size < WS_END) { fprintf(stderr, "kernel_launch: unexpected problem shape (n_in %d, out %d, ws %zu)\n", n_in, out_size, ws_size); grid = -1; return; }
        int dev = 0, cus = 0, per_cu = 0;
        (void)hipGetDevice(&dev); (void)hipDeviceGetAttribute(&cus, hipDeviceAttributeMultiprocessorCount, dev);
        if (hipFuncSetAttribute((const void*)fwd_kernel, hipFuncAttributeMaxDynamicSharedMemorySize, LDS_BYTES) != hipSuccess) { fprintf(stderr, "kernel_launch: hipFuncSetAttribute failed\n"); }
        if (hipOccupancyMaxActiveBlocksPerMultiprocessor(&per_cu, (const void*)fwd_kernel, NTHR, LDS_BYTES) != hipSuccess || per_cu < 1) { fprintf(stderr, "kernel_launch: occupancy query gave %d; using 1\n", per_cu); per_cu = 1; }
        (void)hipGetLastError();
        grid = cus * per_cu;
    }
    if (grid < 0) return;
    if (hipMemsetAsync((char*)d_ws + WS_BAR, 0, XCD_BAR_WORDS * 4, stream) != hipSuccess) { fprintf(stderr, "kernel_launch: hipMemsetAsync failed\n"); return; }
    Args a{};
    for (int i = 0; i < 13; ++i) a.in[i] = (const float*)d_in[i];
    a.out = (float*)d_out; a.ws = (unsigned char*)d_ws;
    void* args[] = {&a};
    const hipError_t e = hipLaunchCooperativeKernel((const void*)fwd_kernel, dim3(grid), dim3(NTHR), args, LDS_BYTES, stream);
    if (e != hipSuccess) fprintf(stderr, "kernel_launch: cooperative launch failed: %s (grid %d)\n", hipGetErrorString(e), grid);
}
```

```cpp
#include <hip/hip_runtime.h>
#include <hip/hip_cooperative_groups.h>
#include <cstdio>
#include <cstdint>
namespace cg = cooperative_groups;
namespace pg8 {
#define PG8_LAS __attribute__((address_space(3)))
typedef unsigned short bf16_t;
typedef short bf16x8 __attribute__((ext_vector_type(8)));
typedef float f32x4 __attribute__((ext_vector_type(4)));
typedef unsigned u32x4 __attribute__((ext_vector_type(4)));
constexpr int BM = 256, BK = 64, HALF = 128, HTB = HALF * BK * 2  , STAGE_BYTES = 8 * HTB, NXCD = 8, WGM = 8;

__host__ __device__ __forceinline__ int lds_byte(int r, int c) { const int st = (r >> 4) * 2 + (c >> 5), rr = r & 15, cc = c & 31, ob = rr * 64 + cc * 2; return st * 1024 + (ob ^ (((ob >> 9) & 1) << 5)); }
__host__ __device__ __forceinline__ void stage_rc(int b, int& R, int& C) { const int st = b / 1024, sb = b % 1024, swz = sb ^ (((sb >> 9) & 1) << 5); R = (st >> 1) * 16 + swz / 64; C = (st & 1) * 32 + (swz % 64) / 2; }
__host__ __device__ __forceinline__ int perm32(int rho) { const int n = rho >> 4, i = rho & 15; return 8 * (i >> 2) + 4 * n + (i & 3); }

struct Unit { int pm, pn; };
struct Gemm { const bf16_t* A; const bf16_t* Bt; int M, N, K; };

struct StaticOrder {
    int nM, nN, nwg, G, c;
    __host__ __device__ void init(int M, int N, int G_, int c_) { nM = M / BM; nN = N / BM; nwg = nM * nN; G = G_; c = c_; }
    __host__ __device__ bool next(int i, Unit& u) const {
        const long L = (long)i * G + c; if (L >= nwg) return false;
        int wgid = (int)L; { const int q = nwg / NXCD, r = nwg % NXCD, xcd = wgid % NXCD, off = wgid / NXCD; wgid = (xcd < r ? xcd * (q + 1) : r * (q + 1) + (xcd - r) * q) + off; }
        const int nig = WGM * nN, gid = wgid / nig, fm = gid * WGM, gsz = (nM - fm) < WGM ? (nM - fm) : WGM;
        u.pm = fm + ((wgid % nig) % gsz); u.pn = (wgid % nig) / gsz; return true;
    }
    __device__ __forceinline__ void a_ready(const Unit&) const {}
    __device__ __forceinline__ void done(const Unit&) const {}
};

__device__ __forceinline__ unsigned cvt_pk_bf16(float lo, float hi) { unsigned r; asm volatile("v_cvt_pk_bf16_f32 %0, %1, %2" : "=v"(r) : "v"(lo), "v"(hi)); return r; }
typedef float f32x2 __attribute__((ext_vector_type(2)));
__device__ __forceinline__ f32x2 gelu_pk(f32x2 v) {
    const f32x2 av = __builtin_elementwise_abs(v), d = av * 0.2316418882f + 1.0f;
    f32x2 t; t.x = __builtin_amdgcn_rcpf(d.x); t.y = __builtin_amdgcn_rcpf(d.y);
    f32x2 q = t * 0.5307027145f + (-0.7265760135f); q = q * t + 0.7107068705f; q = q * t + (-0.142248368f); q = q * t + 0.127414796f; q = q * t;
    const f32x2 s = (v * v) * (-0.72134752044f);
    f32x2 e; e.x = __builtin_amdgcn_exp2f(s.x); e.y = __builtin_amdgcn_exp2f(s.y);
    const f32x2 m = v * (q * e), r = v - m;
    f32x2 o; o.x = v.x < 0.f ? m.x : r.x; o.y = v.y < 0.f ? m.y : r.y; return o;
}

template <int ACT  > struct EpiBf16 {
    static constexpr bool PERM = true, AFTER_DRAIN = false; static_assert(ACT == 0 || ACT == 1, "EpiBf16: ACT is 0 (none) or 1 (gelu_pk)");
    bf16_t* O; int ldc; const float* bias; int split_cols; size_t split_stride; float scale0;
    __device__ __forceinline__ void operator()(const f32x4 (&acc)[2][2][4][2], const Unit& u, int wr, int wc, int fr, int fq) const {
        const int row0 = u.pm * BM + wr * 64 + fr; int colt = u.pn * BM; bf16_t* base = O;
        float sc = 1.f; if (split_cols) { const int t = colt / split_cols; base += (size_t)t * split_stride; colt -= t * split_cols; if (t == 0) sc = scale0; }
        const int col0 = colt + wc * 32 + 8 * fq, bcol0 = u.pn * BM + wc * 32 + 8 * fq;
        f32x4 bv[2][2];
#pragma unroll
        for (int bj = 0; bj < 2; ++bj)
#pragma unroll
            for (int n = 0; n < 2; ++n) bv[bj][n] = bias ? *(const f32x4*)(bias + bcol0 + bj * HALF + 4 * n) : (f32x4){0.f, 0.f, 0.f, 0.f};
#pragma unroll
        for (int ai = 0; ai < 2; ++ai)
#pragma unroll
            for (int m = 0; m < 4; ++m) { bf16_t* rowp = base + (size_t)(row0 + ai * HALF + m * 16) * ldc + col0;
#pragma unroll
                for (int bj = 0; bj < 2; ++bj) { f32x4 v0 = acc[ai][bj][m][0] + bv[bj][0], v1 = acc[ai][bj][m][1] + bv[bj][1];
                    if (ACT == 1) { f32x2 a = gelu_pk((f32x2){v0[0], v0[1]}), b = gelu_pk((f32x2){v0[2], v0[3]}), c = gelu_pk((f32x2){v1[0], v1[1]}), d = gelu_pk((f32x2){v1[2], v1[3]});
                        v0 = (f32x4){a.x, a.y, b.x, b.y}; v1 = (f32x4){c.x, c.y, d.x, d.y}; }
                    v0 = v0 * sc; v1 = v1 * sc; u32x4 w; w.x = cvt_pk_bf16(v0[0], v0[1]); w.y = cvt_pk_bf16(v0[2], v0[3]); w.z = cvt_pk_bf16(v1[0], v1[1]); w.w = cvt_pk_bf16(v1[2], v1[3]);
                    *(u32x4*)(rowp + bj * HALF) = w; } }
    }
};
template <class Epi, class Sched, bool ALIGN_EPI = false, bool SP2 = false>
__device__ __forceinline__ void gemm_phase(PG8_LAS unsigned char* lds, const Gemm g, const Sched& S, const Epi& E) {
    int tid_ = threadIdx.x; asm volatile("" : "+v"(tid_));
    const int tid = tid_, wid = __builtin_amdgcn_readfirstlane(tid >> 6), lane = tid & 63, wr = wid >> 2, wc = wid & 3, fr = lane & 15, fq = lane >> 4;
    const int K = g.K, nt = K / BK;
    unsigned voffA[2], voffB[2];
#pragma unroll
    for (int i = 0; i < 2; ++i) { int R, C; stage_rc(tid * 16 + i * 8192, R, C); const int Rb = Epi::PERM ? ((R & ~31) + perm32(R & 31)) : R;
        voffA[i] = (unsigned)(R * K + C) * 2u; voffB[i] = (unsigned)(Rb * K + C) * 2u; }
    const size_t kstep = (size_t)(BK * 2);
    const size_t hstep = (size_t)HALF * K * 2;
    const size_t tstep = 2 * hstep;
    const unsigned ldsw = (unsigned)wid * 1024u;
    const int aoff = lds_byte(wr * 64 + fr, fq * 8), boff = lds_byte(wc * 32 + fr, fq * 8);
#define PG8_SA(b, h) (((b) * 2 + (h)) * HTB)
#define PG8_SB(b, h) ((4 + (b) * 2 + (h)) * HTB)
#define PG8_STAGE(bufoff, gbase, voff) do { _Pragma("unroll") for (int _i = 0; _i < 2; ++_i) \
        __builtin_amdgcn_global_load_lds((const unsigned*)((const char*)(gbase) + (voff)[_i]), (PG8_LAS unsigned*)(lds + (bufoff) + ldsw + _i * 8192), 16, 0, 0); } while (0)
#define PG8_LDA(dst, b, h) do { _Pragma("unroll") for (int m = 0; m < 4; ++m) _Pragma("unroll") for (int k = 0; k < 2; ++k) dst[m][k] = *(const PG8_LAS bf16x8*)(lds + PG8_SA(b, h) + aoff + m * 2048 + k * 1024); } while (0)
#define PG8_LDB(dst, b, h) do { _Pragma("unroll") for (int n = 0; n < 2; ++n) _Pragma("unroll") for (int k = 0; k < 2; ++k) dst[n][k] = *(const PG8_LAS bf16x8*)(lds + PG8_SB(b, h) + boff + n * 2048 + k * 1024); } while (0)
#define PG8_MMA(ai, bj, At, Bt) do { __builtin_amdgcn_s_setprio(1); _Pragma("unroll") for (int m = 0; m < 4; ++m) _Pragma("unroll") for (int n = 0; n < 2; ++n) _Pragma("unroll") for (int k = 0; k < 2; ++k) \
        acc[ai][bj][m][n] = __builtin_amdgcn_mfma_f32_16x16x32_bf16(Bt[n][k], At[m][k], acc[ai][bj][m][n], 0, 0, 0); __builtin_amdgcn_s_setprio(0); } while (0)
#define PG8_WAIT_V(n) asm volatile("s_waitcnt vmcnt(" #n ")" ::: "memory")
#define PG8_WAIT_L(n) asm volatile("s_waitcnt lgkmcnt(" #n ")" ::: "memory")
#define PG8_BAR __builtin_amdgcn_s_barrier()
#define PG8_SCHED __builtin_amdgcn_sched_barrier(0)
    Unit cur, nxt; int ui = 0;
    if (!S.next(0, cur)) return;
    f32x4 acc[2][2][4][2];
#pragma unroll
    for (int a = 0; a < 2; ++a)
#pragma unroll
        for (int b = 0; b < 2; ++b)
#pragma unroll
            for (int m = 0; m < 4; ++m)
#pragma unroll
                for (int n = 0; n < 2; ++n) acc[a][b][m][n] = (f32x4){0.f, 0.f, 0.f, 0.f};
    bf16x8 At[4][2], B0[2][2], B1[2][2];
    const char* cA = (const char*)g.A + (size_t)cur.pm * tstep; const char* cB = (const char*)g.Bt + (size_t)cur.pn * tstep;
    S.a_ready(cur);
    if constexpr (SP2) {
        PG8_STAGE(PG8_SB(0, 0), cB, voffB); PG8_STAGE(PG8_SB(0, 1), cB + hstep, voffB); PG8_STAGE(PG8_SA(0, 0), cA, voffA); PG8_STAGE(PG8_SA(0, 1), cA + hstep, voffA);
        if (wr == 1) PG8_BAR;
        PG8_WAIT_V(2); PG8_BAR;
        PG8_STAGE(PG8_SB(1, 0), cB + kstep, voffB); PG8_STAGE(PG8_SA(1, 0), cA + kstep, voffA); PG8_STAGE(PG8_SB(1, 1), cB + hstep + kstep, voffB);
        PG8_WAIT_V(6); PG8_BAR;
    } else {
        PG8_STAGE(PG8_SB(0, 0), cB, voffB); PG8_STAGE(PG8_SA(0, 0), cA, voffA); PG8_STAGE(PG8_SB(0, 1), cB + hstep, voffB); PG8_STAGE(PG8_SA(0, 1), cA + hstep, voffA);
        if (wr == 1) PG8_BAR;
        PG8_WAIT_V(4); PG8_BAR;
        PG8_STAGE(PG8_SB(1, 0), cB + kstep, voffB); PG8_STAGE(PG8_SA(1, 0), cA + kstep, voffA); PG8_STAGE(PG8_SB(1, 1), cB + hstep + kstep, voffB);
        PG8_WAIT_V(6); PG8_BAR;
    }
    for (;;) {
        const bool has_next = S.next(ui + 1, nxt);
        const char* nA = has_next ? (const char*)g.A + (size_t)nxt.pm * tstep : cA; const char* nB = has_next ? (const char*)g.Bt + (size_t)nxt.pn * tstep : cB;
        for (int t = 0; t < nt; t += 2) {
            const bool last = (t == nt - 2);
            const char* a1 = cA + (size_t)(t + 1) * kstep;
            const char* a2 = last ? nA : cA + (size_t)(t + 2) * kstep; const char* b2 = last ? nB : cB + (size_t)(t + 2) * kstep;
            const char* a3 = a2 + kstep; const char* b3 = b2 + kstep;
            if (last && has_next) S.a_ready(nxt);
            if constexpr (SP2) {
            PG8_LDB(B0, 0, 0); PG8_LDB(B1, 0, 1); PG8_SCHED; PG8_LDA(At, 0, 0); PG8_STAGE(PG8_SA(1, 1), a1 + hstep, voffA);
            PG8_WAIT_V(8); PG8_WAIT_L(0); PG8_BAR; PG8_MMA(0, 0, At, B0); PG8_MMA(0, 1, At, B1); PG8_BAR; PG8_SCHED;
            PG8_LDA(At, 0, 1); PG8_STAGE(PG8_SB(0, 0), b2, voffB); PG8_STAGE(PG8_SB(0, 1), b2 + hstep, voffB); PG8_STAGE(PG8_SA(0, 0), a2, voffA);
            PG8_WAIT_V(8); PG8_WAIT_L(0); PG8_BAR; PG8_MMA(1, 0, At, B0); PG8_MMA(1, 1, At, B1); PG8_BAR; PG8_SCHED;
            PG8_LDB(B0, 1, 0); PG8_LDB(B1, 1, 1); PG8_SCHED; PG8_LDA(At, 1, 0); PG8_STAGE(PG8_SA(0, 1), a2 + hstep, voffA);
            PG8_WAIT_V(8); PG8_WAIT_L(0); PG8_BAR; PG8_MMA(0, 0, At, B0); PG8_MMA(0, 1, At, B1); PG8_BAR; PG8_SCHED;
            PG8_LDA(At, 1, 1); PG8_STAGE(PG8_SB(1, 0), b3, voffB); PG8_STAGE(PG8_SB(1, 1), b3 + hstep, voffB); PG8_STAGE(PG8_SA(1, 0), a3, voffA);
            PG8_WAIT_V(8); PG8_WAIT_L(0); PG8_BAR; PG8_MMA(1, 0, At, B0); PG8_MMA(1, 1, At, B1); PG8_BAR; PG8_SCHED;
            } else {
            PG8_LDB(B0, 0, 0); PG8_SCHED; PG8_LDA(At, 0, 0); PG8_STAGE(PG8_SA(1, 1), a1 + hstep, voffA);
            PG8_WAIT_L(8); PG8_BAR; PG8_WAIT_L(0); PG8_MMA(0, 0, At, B0); PG8_BAR; PG8_SCHED;
            PG8_LDB(B1, 0, 1); PG8_STAGE(PG8_SB(0, 0), b2, voffB);
            PG8_BAR; PG8_WAIT_L(0); PG8_MMA(0, 1, At, B1); PG8_BAR;
            PG8_LDA(At, 0, 1); PG8_STAGE(PG8_SA(0, 0), a2, voffA);
            PG8_BAR; PG8_WAIT_L(0); PG8_MMA(1, 0, At, B0); PG8_BAR; PG8_SCHED;
            PG8_STAGE(PG8_SB(0, 1), b2 + hstep, voffB);
            PG8_WAIT_V(6); PG8_BAR; PG8_MMA(1, 1, At, B1); PG8_BAR;
            PG8_LDB(B0, 1, 0); PG8_SCHED; PG8_LDA(At, 1, 0); PG8_STAGE(PG8_SA(0, 1), a2 + hstep, voffA);
            PG8_WAIT_L(8); PG8_BAR; PG8_WAIT_L(0); PG8_MMA(0, 0, At, B0); PG8_BAR; PG8_SCHED;
            PG8_LDB(B1, 1, 1); PG8_STAGE(PG8_SB(1, 0), b3, voffB);
            PG8_BAR; PG8_WAIT_L(0); PG8_MMA(0, 1, At, B1); PG8_BAR;
            PG8_LDA(At, 1, 1); PG8_STAGE(PG8_SA(1, 0), a3, voffA);
            PG8_BAR; PG8_WAIT_L(0); PG8_MMA(1, 0, At, B0); PG8_BAR; PG8_SCHED;
            PG8_STAGE(PG8_SB(1, 1), b3 + hstep, voffB);
            PG8_WAIT_V(6); PG8_BAR; PG8_MMA(1, 1, At, B1); PG8_BAR;
            }
        }
        if constexpr (ALIGN_EPI) { if (wr == 0) PG8_BAR; }
        if constexpr (!Epi::AFTER_DRAIN) { E(acc, cur, wr, wc, fr, fq); S.done(cur); }
        if (!has_next) break;
#pragma unroll
        for (int a = 0; a < 2; ++a)
#pragma unroll
            for (int b = 0; b < 2; ++b)
#pragma unroll
                for (int m = 0; m < 4; ++m)
#pragma unroll
                    for (int n = 0; n < 2; ++n) acc[a][b][m][n] = (f32x4){0.f, 0.f, 0.f, 0.f};
        cur = nxt; cA = nA; cB = nB; ++ui;
        if constexpr (ALIGN_EPI) { if (wr == 1) PG8_BAR; }
    }
    PG8_WAIT_V(0);
    if constexpr (!ALIGN_EPI) { if (wr == 0) PG8_BAR; }
    PG8_BAR;
    if constexpr (Epi::AFTER_DRAIN) { E.fused(acc, cur, wr, wc, fr, fq, lds, wid, lane); S.done(cur); }
#undef PG8_SA
#undef PG8_SB
#undef PG8_STAGE
#undef PG8_LDA
#undef PG8_LDB
#undef PG8_MMA
#undef PG8_WAIT_V
#undef PG8_WAIT_L
#undef PG8_BAR
#undef PG8_SCHED
}
}
#ifndef DBG_STAGE
#define DBG_STAGE 0
#endif
#ifndef DBG_SKIP
#define DBG_SKIP 0
#endif
constexpr int BATCH = 8, SEQ = 4096, D = 1024, NH = 16, HD = 64, FF = 2816, FF2 = 2 * FF, DEPTH = 4;
constexpr int M = BATCH * SEQ;
constexpr float NORM_EPS = 1e-6f;
constexpr float LOG2E = 1.4426950408889634f;
constexpr float QSCALE = 0.125f * LOG2E;
constexpr int NWAVES = 8, NTHR = 512;

#define LAS __attribute__((address_space(3)))
typedef unsigned short bf16;
typedef float f32x4 __attribute__((ext_vector_type(4)));
typedef float f32x16 __attribute__((ext_vector_type(16)));
typedef short bf16x8 __attribute__((ext_vector_type(8)));
typedef unsigned u32x4 __attribute__((ext_vector_type(4)));
typedef unsigned u32x2 __attribute__((ext_vector_type(2)));

constexpr size_t MiB = 1u << 20;
constexpr size_t W_LAYER = 25 * MiB;
constexpr size_t WO_QK = 0, WO_V = 4 * MiB, WO_O = 6 * MiB, WO_UP = 8 * MiB, WO_DN = 19 * MiB;
constexpr size_t WS_W = 0;
constexpr size_t WS_BAR = 99 * MiB + 576 * 1024;
constexpr size_t WS_FLOG = 100 * MiB;
constexpr size_t WS_C2 = 102 * MiB;
constexpr size_t WS_EDGE = 104 * MiB;
constexpr size_t WS_RAW01 = 110 * MiB;
constexpr size_t WS_XN = 116 * MiB;
constexpr size_t WS_QO = 180 * MiB;
constexpr size_t WS_K = 244 * MiB;
constexpr size_t WS_VT = 308 * MiB;
constexpr size_t WS_ACT = 180 * MiB;
constexpr size_t WS_HSB = 372 * MiB;
constexpr size_t WS_END = 436 * MiB;
static_assert(WS_ACT + (size_t)M * FF * 2 <= WS_END, "ws map");

constexpr int RING_BYTES = 131072, XCH_OFF = RING_BYTES, MISC_OFF = XCH_OFF + 8192, PTAB_OFF = MISC_OFF + 256, TIME_OFF = MISC_OFF + 512, WL_OFF = MISC_OFF + 1024, LDS_BYTES = 147456;

typedef float f32x2_t __attribute__((ext_vector_type(2))); typedef __bf16 bf16x2_t __attribute__((ext_vector_type(2)));
__device__ __forceinline__ unsigned cvtpk(float lo, float hi) { f32x2_t v = {lo, hi}; bf16x2_t b = __builtin_convertvector(v, bf16x2_t); return __builtin_bit_cast(unsigned, b); }
__device__ __forceinline__ float wave_sum(float v) {
#pragma unroll
    for (int o = 1; o < 64; o <<= 1) v += __shfl_xor(v, o);
    return v;
}
__device__ __forceinline__ float ex2(float x) { return __builtin_amdgcn_exp2f(x); }
__device__ __forceinline__ float lg2(float x) { return __builtin_amdgcn_logf(x); }
__device__ __forceinline__ float bflo(unsigned w) { return __uint_as_float(w << 16); }
__device__ __forceinline__ float bfhi(unsigned w) { return __uint_as_float(w & 0xffff0000u); }
template <bool BASE_F32>
struct EpiResid {
    static constexpr bool PERM = true, AFTER_DRAIN = false;
    const void* base; bf16* out;
    __device__ __forceinline__ void operator()(const pg8::f32x4 (&acc)[2][2][4][2], const pg8::Unit& u, int wr, int wc, int fr, int fq) const {
        const int row0 = u.pm * 256 + wr * 64 + fr, col0 = u.pn * 256 + wc * 32 + 8 * fq;
#pragma unroll
        for (int ai = 0; ai < 2; ++ai)
#pragma unroll
            for (int m = 0; m < 4; ++m) { const size_t off = (size_t)(row0 + ai * 128 + m * 16) * D + col0;
#pragma unroll
                for (int bj = 0; bj < 2; ++bj) { f32x4 b0, b1;
                    if (BASE_F32) { b0 = *(const f32x4*)((const float*)base + off + bj * 128); b1 = *(const f32x4*)((const float*)base + off + bj * 128 + 4); }
                    else { const u32x4 w = *(const u32x4*)((const bf16*)base + off + bj * 128); b0 = (f32x4){bflo(w.x), bfhi(w.x), bflo(w.y), bfhi(w.y)}; b1 = (f32x4){bflo(w.z), bfhi(w.z), bflo(w.w), bfhi(w.w)}; }
                    const f32x4 r0 = b0 + acc[ai][bj][m][0], r1 = b1 + acc[ai][bj][m][1];
                    u32x4 o; o.x = cvtpk(r0[0], r0[1]); o.y = cvtpk(r0[2], r0[3]); o.z = cvtpk(r1[0], r1[1]); o.w = cvtpk(r1[2], r1[3]);
                    *(u32x4*)(out + off + bj * 128) = o; }
                asm volatile("" ::: "memory"); }
    }
};

__device__ __forceinline__ float dpp_ror1(float v) { return __builtin_bit_cast(float, __builtin_amdgcn_mov_dpp(__builtin_bit_cast(int, v), 0x121, 0xf, 0xf, false)); }
__device__ __forceinline__ float dpp_shr1_old(float old_, float v) { return __builtin_bit_cast(float, __builtin_amdgcn_update_dpp(__builtin_bit_cast(int, old_), __builtin_bit_cast(int, v), 0x111, 0xf, 0xf, false)); }
__device__ __forceinline__ float dpp_shr2_old(float old_, float v) { return __builtin_bit_cast(float, __builtin_amdgcn_update_dpp(__builtin_bit_cast(int, old_), __builtin_bit_cast(int, v), 0x112, 0xf, 0xf, false)); }
__device__ __forceinline__ float dpp_ror2(float v) { return __builtin_bit_cast(float, __builtin_amdgcn_mov_dpp(__builtin_bit_cast(int, v), 0x122, 0xf, 0xf, false)); }

struct EpiConvGate {
    static constexpr bool PERM = true, AFTER_DRAIN = false;
    bf16* act; const float* wconv; const float* bconv; float* edge; float* raw01; LAS float* xch;
    __device__ __forceinline__ void operator()(const pg8::f32x4 (&acc)[2][2][4][2], const pg8::Unit& u, int wr, int wc, int fr, int fq) const {
        const int lc0 = wc * 32 + 8 * fq, ch0 = u.pn * 128 + lc0;
        if (fr >= 14) {
#pragma unroll
            for (int ai = 0; ai < 2; ++ai) { const int q = 2 * ai + wr;
#pragma unroll
                for (int bj = 0; bj < 2; ++bj)
#pragma unroll
                    for (int n = 0; n < 2; ++n) *(LAS f32x4*)(xch + (q * 2 + (fr - 14)) * 256 + bj * 128 + lc0 + 4 * n) = acc[ai][bj][3][n]; }
            if (wr == 1) {
#pragma unroll
                for (int bj = 0; bj < 2; ++bj)
#pragma unroll
                    for (int n = 0; n < 2; ++n) *(f32x4*)(edge + ((size_t)u.pm * 2 + (fr - 14)) * FF2 + bj * FF + ch0 + 4 * n) = acc[1][bj][3][n]; }
        }
        if (wr == 0 && fr < 2) {
#pragma unroll
            for (int bj = 0; bj < 2; ++bj)
#pragma unroll
                for (int n = 0; n < 2; ++n) *(f32x4*)(raw01 + ((size_t)u.pm * 2 + fr) * FF2 + bj * FF + ch0 + 4 * n) = acc[0][bj][0][n];
        }
        asm volatile("s_waitcnt lgkmcnt(0)" ::: "memory"); __builtin_amdgcn_s_barrier(); asm volatile("" ::: "memory");
#pragma unroll
        for (int n = 0; n < 2; ++n) {
            const f32x4 wu0 = *(const f32x4*)(wconv + ch0 + 4 * n), wu1 = *(const f32x4*)(wconv + FF2 + ch0 + 4 * n), wu2 = *(const f32x4*)(wconv + 2 * FF2 + ch0 + 4 * n), bu = *(const f32x4*)(bconv + ch0 + 4 * n);
            const f32x4 wg0 = *(const f32x4*)(wconv + FF + ch0 + 4 * n), wg1 = *(const f32x4*)(wconv + FF2 + FF + ch0 + 4 * n), wg2 = *(const f32x4*)(wconv + 2 * FF2 + FF + ch0 + 4 * n), bg = *(const f32x4*)(bconv + FF + ch0 + 4 * n);
#pragma unroll
            for (int ai = 0; ai < 2; ++ai) {
                const int q = 2 * ai + wr;
                f32x4 pru = (f32x4){0.f, 0.f, 0.f, 0.f}, prg = pru;
                if (q > 0 && fr >= 14) { pru = *(const LAS f32x4*)(xch + ((q - 1) * 2 + (fr - 14)) * 256 + lc0 + 4 * n); prg = *(const LAS f32x4*)(xch + ((q - 1) * 2 + (fr - 14)) * 256 + 128 + lc0 + 4 * n); }
#pragma unroll
                for (int m = 0; m < 4; ++m) {
                    float r4[4];
#pragma unroll
                    for (int j = 0; j < 4; ++j) {
                        const float vu = acc[ai][0][m][n][j], vg = acc[ai][1][m][n][j];
                        const float pu = m > 0 ? acc[ai][0][m > 0 ? m - 1 : 0][n][j] : pru[j];
                        const float pg = m > 0 ? acc[ai][1][m > 0 ? m - 1 : 0][n][j] : prg[j];
                        const float u1 = dpp_shr1_old(dpp_ror1(pu), vu), u2 = dpp_shr2_old(dpp_ror2(pu), vu);
                        const float g1 = dpp_shr1_old(dpp_ror1(pg), vg), g2 = dpp_shr2_old(dpp_ror2(pg), vg);
                        const float nb = (DBG_STAGE == 21) ? 0.f : 1.f;
                        const float hu = bu[j] + wu2[j] * vu + nb * (wu1[j] * u1 + wu0[j] * u2);
                        const float hg = bg[j] + wg2[j] * vg + nb * (wg1[j] * g1 + wg0[j] * g2);
                        const float sg = hg * __builtin_amdgcn_rcpf(1.f + ex2(-hg * LOG2E));
                        r4[j] = sg * hu;
                    }
                    const int row = u.pm * 256 + ai * 128 + wr * 64 + m * 16 + fr;
                    u32x2 w; w.x = cvtpk(r4[0], r4[1]); w.y = cvtpk(r4[2], r4[3]);
                    if (!(ai == 0 && m == 0 && wr == 0 && fr < 2)) *(u32x2*)(act + (size_t)row * FF + ch0 + 4 * n) = w;
                    asm volatile("" ::: "memory");
                }
            }
        }
    }
};
constexpr int A_ROWB = 144, A_KBUF = 64 * A_ROWB, A_OFF_K = 0, A_OFF_V = 2 * A_KBUF, A_OFF_FLAG = 5 * A_KBUF;

__device__ __forceinline__ float lane_partner(float v, int hi) {
    auto rr = __builtin_amdgcn_permlane32_swap(__float_as_uint(v), __float_as_uint(v), false, false);
    return __uint_as_float(hi ? rr[0] : rr[1]);
}

template <int MODE>
__device__ __forceinline__ void attn_unit(int b, int h, int qb, const bf16* Q, const bf16* __restrict__ K, const bf16* __restrict__ VT, const float* __restrict__ C2, bf16* O, LAS unsigned char* lds) {
    int tid_ = threadIdx.x; asm volatile("" : "+v"(tid_));
    const int tid = tid_, lane = tid & 63, r32 = lane & 31, hi = lane >> 5; const int wid = __builtin_amdgcn_readfirstlane(tid >> 6);
    const size_t rowbase = (size_t)b * SEQ; const int q0 = qb * 256; const int NT = (q0 + 256) / 64;
    const int qabs = q0 + wid * 32 + r32;
    const bf16* Qw = Q + (rowbase + qabs) * D + h * 64;
    bf16x8 qr[4];
#pragma unroll
    for (int d0 = 0; d0 < 4; ++d0) qr[d0] = *(const bf16x8*)(Qw + d0 * 16 + hi * 8);
    const int lrow = tid >> 3, lch = tid & 7;
    const bf16* ksrc = K + (rowbase + lrow) * D + h * 64 + lch * 8;
    const bf16* vsrc = VT + (size_t)(h * 64 + lrow) * M + rowbase + lch * 8;
    const float* csrc = C2 + ((size_t)(b * NH + h)) * SEQ + lrow;
    const int ldst = lrow * A_ROWB + lch * 16;
    const int krow = (r32 & ~12) | ((r32 & 4) << 1) | ((r32 & 8) >> 1);
    const int koff = krow * A_ROWB + hi * 16, voff = r32 * A_ROWB + hi * 16;
    u32x4 kregs[2], vregs[2]; float cregs[2] = {0.f, 0.f};
#define A_TILE(i) (NT - 1 - (i))
#define A_LOAD(t, S) do { kregs[S] = *(const u32x4*)(ksrc + (size_t)(t) * 64 * D); vregs[S] = *(const u32x4*)(vsrc + (t) * 64); if (MODE == 0) cregs[S] = csrc[(t) * 64]; } while (0)
#define A_WRITE(buf, vbuf_, S) do { *(LAS u32x4*)(lds + A_OFF_K + (buf) * A_KBUF + ldst) = kregs[S]; *(LAS u32x4*)(lds + A_OFF_V + (vbuf_) * A_KBUF + ldst) = vregs[S]; \
        if (MODE == 0 && lch == 0) { const float nb_ = -cregs[S]; const unsigned hb_ = cvtpk(nb_, 0.f) & 0xffffu; const float rem_ = nb_ - __uint_as_float(hb_ << 16); \
            *(LAS u32x4*)(lds + A_OFF_K + (buf) * A_KBUF + lrow * A_ROWB + 128) = (u32x4){hb_ | (cvtpk(rem_, 0.f) << 16), 0u, 0u, 0u}; } } while (0)
    f32x16 o0, o1;
#pragma unroll
    for (int r = 0; r < 16; ++r) { o0[r] = 0.f; o1[r] = 0.f; }
    float mrun = -INFINITY, lrun = 0.f, carry = 1.f;
    f32x16 negm; bool started = false;
#pragma unroll
    for (int r = 0; r < 16; ++r) negm[r] = 0.f;
    const bf16x8 qone = hi ? (bf16x8){0, 0, 0, 0, 0, 0, 0, 0} : (bf16x8){0x3f80, 0x3f80, 0, 0, 0, 0, 0, 0};
    if (MODE == 0 && tid == 0) *(LAS u32x4*)(lds + A_OFF_FLAG + 64) = (u32x4){0u, 0u, 0u, 0u};
    A_LOAD(A_TILE(0), 0); A_WRITE(0, 0, 0);
    A_LOAD(A_TILE(1), 1);
    asm volatile("" : "+v"(qr[0]), "+v"(qr[1]), "+v"(qr[2]), "+v"(qr[3]));
    __syncthreads();
    const bool lag = true; bool pend = false; bf16x8 P[4];
#pragma unroll
    for (int ii = 0; ii < 4; ++ii) P[ii] = (bf16x8){0, 0, 0, 0, 0, 0, 0, 0};
    int vbuf = 0, vprev = 0;
#define A_PV(vslot) do { const LAS unsigned char* vb_ = lds + A_OFF_V + (vslot) * A_KBUF; bf16x8 vf0_[4], vf1_[4]; \
        _Pragma("unroll") for (int ii = 0; ii < 4; ++ii) { vf0_[ii] = *(const LAS bf16x8*)(vb_ + voff + ii * 32); vf1_[ii] = *(const LAS bf16x8*)(vb_ + 32 * A_ROWB + voff + ii * 32); } \
        __builtin_amdgcn_sched_barrier(0);     \
        __builtin_amdgcn_s_setprio(1); \
        _Pragma("unroll") for (int ii = 0; ii < 4; ++ii) { o0 = __builtin_amdgcn_mfma_f32_32x32x16_bf16(vf0_[ii], P[ii], o0, 0, 0, 0); o1 = __builtin_amdgcn_mfma_f32_32x32x16_bf16(vf1_[ii], P[ii], o1, 0, 0, 0); } \
        __builtin_amdgcn_s_setprio(0); } while (0)
    bool stop = false, wdone = false;
    for (int ip = 0; ip < NT / 2 && !stop; ++ip) {
#pragma unroll
    for (int sub = 0; sub < 2; ++sub) {
        const int i = 2 * ip + sub;
        const int buf = sub, t = A_TILE(i);
        { const int t2_ = A_TILE(i + 2); A_LOAD(t2_ < 0 ? 0 : t2_, sub); }
        const LAS unsigned char* kb = lds + A_OFF_K + buf * A_KBUF;
        const bool vis_ = 64 * t <= q0 + wid * 32 + 31 && !(MODE == 1 && wdone);
        if (MODE == 1 && pend && !vis_) { A_PV(vprev); pend = false;
#pragma unroll
            for (int ii = 0; ii < 4; ++ii) P[ii] = (bf16x8){0, 0, 0, 0, 0, 0, 0, 0}; }
        if (vis_) {
        f32x16 s0, s1;
        {
            bf16x8 kf0_[5], kf1_[5];
#pragma unroll
            for (int d0 = 0; d0 < 4; ++d0) { kf0_[d0] = *(const LAS bf16x8*)(kb + koff + d0 * 32); kf1_[d0] = *(const LAS bf16x8*)(kb + 32 * A_ROWB + koff + d0 * 32); }
            if (MODE == 0) {
                const LAS unsigned char* zp = lds + A_OFF_FLAG + 64;
                const LAS unsigned char* p0 = hi ? zp : kb + krow * A_ROWB + 128; const LAS unsigned char* p1 = hi ? zp : kb + (krow + 32) * A_ROWB + 128;
                kf0_[4] = *(const LAS bf16x8*)p0; kf1_[4] = *(const LAS bf16x8*)p1;
            }
            __builtin_amdgcn_sched_barrier(0);
            __builtin_amdgcn_s_setprio(1);
            s0 = __builtin_amdgcn_mfma_f32_32x32x16_bf16(kf0_[0], qr[0], negm, 0, 0, 0);
            s1 = __builtin_amdgcn_mfma_f32_32x32x16_bf16(kf1_[0], qr[0], negm, 0, 0, 0);
#pragma unroll
            for (int d0 = 1; d0 < 4; ++d0) {
                s0 = __builtin_amdgcn_mfma_f32_32x32x16_bf16(kf0_[d0], qr[d0], s0, 0, 0, 0);
                s1 = __builtin_amdgcn_mfma_f32_32x32x16_bf16(kf1_[d0], qr[d0], s1, 0, 0, 0);
            }
            if (MODE == 0) {
                s0 = __builtin_amdgcn_mfma_f32_32x32x16_bf16(kf0_[4], qone, s0, 0, 0, 0);
                s1 = __builtin_amdgcn_mfma_f32_32x32x16_bf16(kf1_[4], qone, s1, 0, 0, 0);
            }
            __builtin_amdgcn_s_setprio(0);
        }
        const bool band = t >= NT - 4;
        const int kbase = t * 64 + 8 * hi;
        if (MODE == 0) {
            if (band) {
#pragma unroll
                for (int r = 0; r < 16; ++r) { const int key = kbase + (r & 7) + 16 * (r >> 3); if (key > qabs) s0[r] = -INFINITY; if (key + 32 > qabs) s1[r] = -INFINITY; }
            }
            float mx = __builtin_fmaxf(s0[0], s1[0]);
#pragma unroll
            for (int r = 1; r < 16; ++r) mx = __builtin_fmaxf(__builtin_fmaxf(mx, s0[r]), s1[r]);
            mx = fmaxf(mx, lane_partner(mx, hi));
            if (!started) {
                started = true; mrun = mx;
#pragma unroll
                for (int r = 0; r < 16; ++r) { s0[r] -= mx; s1[r] -= mx; negm[r] = -mx; }
            } else if (__any(mx > 8.f)) {
                if (pend) { A_PV(vprev); pend = false;
#pragma unroll
                    for (int ii = 0; ii < 4; ++ii) P[ii] = (bf16x8){0, 0, 0, 0, 0, 0, 0, 0}; }
                const float dl = fmaxf(mx, 0.f), alpha = ex2(-dl);
                lrun *= alpha; mrun += dl;
#pragma unroll
                for (int r = 0; r < 16; ++r) { o0[r] *= alpha; o1[r] *= alpha; s0[r] -= dl; s1[r] -= dl; negm[r] -= dl; }
            }
            {
                const LAS unsigned char* vb_ = lds + A_OFF_V + (pend ? vprev : vbuf) * A_KBUF;
                bf16x8 vf0_[4], vf1_[4];
#pragma unroll
                for (int ii = 0; ii < 4; ++ii) { vf0_[ii] = *(const LAS bf16x8*)(vb_ + voff + ii * 32); vf1_[ii] = *(const LAS bf16x8*)(vb_ + 32 * A_ROWB + voff + ii * 32); }
                float ls = 0.f; bf16x8 Pn[4];
#pragma unroll
                for (int ii = 0; ii < 4; ++ii) {
                    o0 = __builtin_amdgcn_mfma_f32_32x32x16_bf16(vf0_[ii], P[ii], o0, 0, 0, 0); o1 = __builtin_amdgcn_mfma_f32_32x32x16_bf16(vf1_[ii], P[ii], o1, 0, 0, 0);
                    float pv_[8];
#pragma unroll
                    for (int e = 0; e < 8; ++e) { pv_[e] = ex2(ii < 2 ? s0[8 * (ii & 1) + e] : s1[8 * (ii & 1) + e]); ls += pv_[e]; }
                    u32x4 w; w.x = cvtpk(pv_[0], pv_[1]); w.y = cvtpk(pv_[2], pv_[3]); w.z = cvtpk(pv_[4], pv_[5]); w.w = cvtpk(pv_[6], pv_[7]);
                    Pn[ii] = __builtin_bit_cast(bf16x8, w);
                    __builtin_amdgcn_sched_barrier(0);
                }
                lrun += ls; pend = true;
#pragma unroll
                for (int ii = 0; ii < 4; ++ii) P[ii] = Pn[ii];
            }
        } else {
            f32x16 b0, b1;
            {
                const LAS unsigned char* vb_ = lds + A_OFF_V + (pend ? vprev : vbuf) * A_KBUF;
                bf16x8 vf0_[4], vf1_[4];
#pragma unroll
                for (int ii = 0; ii < 4; ++ii) { vf0_[ii] = *(const LAS bf16x8*)(vb_ + voff + ii * 32); vf1_[ii] = *(const LAS bf16x8*)(vb_ + 32 * A_ROWB + voff + ii * 32); }
#pragma unroll
                for (int ii = 0; ii < 4; ++ii) {
                    o0 = __builtin_amdgcn_mfma_f32_32x32x16_bf16(vf0_[ii], P[ii], o0, 0, 0, 0); o1 = __builtin_amdgcn_mfma_f32_32x32x16_bf16(vf1_[ii], P[ii], o1, 0, 0, 0);
#pragma unroll
                    for (int e = 0; e < 8; ++e) { const int r = 8 * (ii & 1) + e;
                        if (ii < 2) { const float z = fmaxf(s0[r], -100.f), ee = ex2(-z), rr = __builtin_amdgcn_rcpf(1.f + ee); b0[r] = ee * rr; s0[r] = rr; }
                        else        { const float z = fmaxf(s1[r], -100.f), ee = ex2(-z), rr = __builtin_amdgcn_rcpf(1.f + ee); b1[r] = ee * rr; s1[r] = rr; } }
                    __builtin_amdgcn_sched_barrier(0);
                }
                pend = false;
            }
            if (band) {
#pragma unroll
                for (int r = 0; r < 16; ++r) { const int key = kbase + (r & 7) + 16 * (r >> 3);
                    if (key >= qabs) { b0[r] = 1.f; s0[r] = 0.f; } if (key + 32 >= qabs) { b1[r] = 1.f; s1[r] = 0.f; } }
            }
            float T[4];
#pragma unroll
            for (int a = 0; a < 4; ++a) { float tt = 1.f;
#pragma unroll
                for (int e = 0; e < 8; ++e) tt *= (a < 2 ? b0[8 * (a & 1) + e] : b1[8 * (a & 1) + e]);
                T[a] = tt; }
            float U[4], tot[4];
#pragma unroll
            for (int a = 0; a < 4; ++a) { U[a] = lane_partner(T[a], hi); tot[a] = T[a] * U[a]; }
            float later = carry;
#pragma unroll
            for (int a = 3; a >= 0; --a) {
                float run = later * (hi == 0 ? U[a] : 1.f);
#pragma unroll
                for (int e = 7; e >= 0; --e) {
                    if (a < 2) { const float lb = b0[8 * (a & 1) + e]; s0[8 * (a & 1) + e] *= run; run *= lb; }
                    else       { const float lb = b1[8 * (a & 1) + e]; s1[8 * (a & 1) + e] *= run; run *= lb; }
                }
                later *= tot[a];
            }
            carry = later;
        }
        if (MODE == 1) {
#pragma unroll
        for (int ii = 0; ii < 4; ++ii) { u32x4 w;
            if (ii < 2) { w.x = cvtpk(s0[8 * ii], s0[8 * ii + 1]); w.y = cvtpk(s0[8 * ii + 2], s0[8 * ii + 3]); w.z = cvtpk(s0[8 * ii + 4], s0[8 * ii + 5]); w.w = cvtpk(s0[8 * ii + 6], s0[8 * ii + 7]); }
            else { const int i2 = ii - 2; w.x = cvtpk(s1[8 * i2], s1[8 * i2 + 1]); w.y = cvtpk(s1[8 * i2 + 2], s1[8 * i2 + 3]); w.z = cvtpk(s1[8 * i2 + 4], s1[8 * i2 + 5]); w.w = cvtpk(s1[8 * i2 + 6], s1[8 * i2 + 7]); }
            P[ii] = __builtin_bit_cast(bf16x8, w); }
        pend = true;
        }
        }
        vprev = vbuf; vbuf = (vbuf == 2) ? 0 : vbuf + 1;
        if (i + 1 < NT) A_WRITE(buf ^ 1, vbuf, sub ^ 1);
        if (MODE == 1) {
            const bool done_w = __all(carry == 0.f); wdone = done_w;
            if (lane == 0) *(LAS unsigned*)(lds + A_OFF_FLAG + (i & 1) * 32 + wid * 4) = done_w ? 1u : 0u;
        }
        __syncthreads();
        if (MODE == 1) {
            const u32x4 f0 = *(const LAS u32x4*)(lds + A_OFF_FLAG + (i & 1) * 32), f1 = *(const LAS u32x4*)(lds + A_OFF_FLAG + (i & 1) * 32 + 16);
            if ((f0.x & f0.y & f0.z & f0.w & f1.x & f1.y & f1.z & f1.w) != 0u) { stop = true; break; }
        }
    }
    }
    if (lag && pend) A_PV(vprev);
    __syncthreads();
    float inv = 1.f;
    if (MODE == 0) { const float lt = lrun + lane_partner(lrun, hi); inv = 1.f / lt; }
    unsigned char* Ob = (unsigned char*)(O + (rowbase + qabs) * D + h * 64) + (hi ? 16 : 0);
    u32x2 wk[8];
#pragma unroll
    for (int k = 0; k < 8; ++k) {
        if (k < 4) { wk[k].x = cvtpk(o0[4 * k] * inv, o0[4 * k + 1] * inv); wk[k].y = cvtpk(o0[4 * k + 2] * inv, o0[4 * k + 3] * inv); }
        else { wk[k].x = cvtpk(o1[4 * (k - 4)] * inv, o1[4 * (k - 4) + 1] * inv); wk[k].y = cvtpk(o1[4 * (k - 4) + 2] * inv, o1[4 * (k - 4) + 3] * inv); }
    }
#pragma unroll
    for (int k = 0; k < 8; k += 2) {
        auto rx = __builtin_amdgcn_permlane32_swap(wk[k].x, wk[k + 1].x, false, false);
        auto ry = __builtin_amdgcn_permlane32_swap(wk[k].y, wk[k + 1].y, false, false);
        *(u32x4*)(Ob + 16 * k) = (u32x4){rx[0], ry[0], rx[1], ry[1]};
    }
#undef A_TILE
#undef A_LOAD
#undef A_WRITE
#undef A_PV
}

template <int MODE>
__device__ __forceinline__ void attn_phase(int vcu, int G, const bf16* Q, const bf16* K, const bf16* VT, const float* C2, bf16* O, LAS unsigned char* lds) {
    for (int v = vcu; v < 256; v += G) {
        const int bh = v >> 1, s = v & 1;
        for (int i = 0; i < 8; ++i) { const int jj = 2 * (i >> 1) + s; const int qb = (i & 1) ? 15 - jj : jj;
            attn_unit<MODE>(bh / NH, bh % NH, qb, Q, K, VT, C2, O, lds); }
    }
}
#define atomicAdd_u(p, v) atomicAdd(p, v)
#define XB_TMO      128
#define XB_XCNT(j)  (256  + 64 * (j))
#define XB_XSUB(j)  (1280 + 64 * (j))
#define XB_XGEN(j)  (2304 + 64 * (j))
#define XB_TOP      3328
#define XB_TOPGEN   3392
#define XCD_BAR_WORDS 3456
#define XB_SPIN_CAP (1u << 18)

__device__ __forceinline__ unsigned xb_ld(unsigned* p)              { return __hip_atomic_load(p, __ATOMIC_RELAXED, __HIP_MEMORY_SCOPE_AGENT); }
__device__ __forceinline__ unsigned xb_add(unsigned* p, unsigned v) { return __hip_atomic_fetch_add(p, v, __ATOMIC_RELAXED, __HIP_MEMORY_SCOPE_AGENT); }
__device__ __forceinline__ unsigned xb_xcc_id() { return (unsigned)__builtin_amdgcn_s_getreg((3 << 11) | 20) & 0xFu; }
#define XB_SPIN(cond, bar) do { unsigned _sp = 0; while (cond) { __builtin_amdgcn_s_sleep(1); \
    if ((++_sp & 255u) == 0u) { if (xb_ld(&(bar)[XB_TMO])) break; if (_sp > XB_SPIN_CAP) { atomicAdd(&(bar)[XB_TMO], 1u); break; } } } } while (0)

struct XcdBarrier {
    unsigned* bar; unsigned x;
    volatile LAS unsigned* st;
};

__device__ __forceinline__ XcdBarrier xcd_barrier_post(unsigned* bar, volatile LAS unsigned* st) {
    XcdBarrier b; b.bar = bar; b.x = xb_xcc_id(); b.st = st;
    if (threadIdx.x == 0) (void)xb_add(&bar[XB_XCNT(b.x)], 1u);
    return b;
}
__device__ __forceinline__ void xcd_barrier_complete(unsigned* bar, unsigned x, unsigned& nloc, unsigned& nx) {
    const unsigned G = gridDim.x * gridDim.y * gridDim.z;
    unsigned sum, cnt, mine, sp = 0u;
    for (;;) {
        sum = 0u; cnt = 0u; mine = 0u;
#pragma unroll
        for (unsigned j = 0; j < 16; ++j) { const unsigned c = xb_ld(&bar[XB_XCNT(j)]); sum += c; cnt += (c > 0u) ? 1u : 0u; mine = (j == x) ? c : mine; }
        if (sum == G) break;
        __builtin_amdgcn_s_sleep(1);
        if ((++sp & 255u) == 0u) { if (xb_ld(&bar[XB_TMO])) break; if (sp > XB_SPIN_CAP) { atomicAdd(&bar[XB_TMO], 1u); break; } }
    }
    nloc = mine > 0u ? mine : 1u; nx = cnt > 0u ? cnt : 1u;
}

__device__ __forceinline__ void xcd_barrier(const XcdBarrier& b) {
    asm volatile("s_waitcnt vmcnt(0)" ::: "memory");
    __syncthreads();
    if (threadIdx.x == 0) {
        unsigned* bar = b.bar;
        __builtin_amdgcn_s_waitcnt(0);
        unsigned nloc = b.st[0], nx = b.st[1];
        if (nloc == 0u) { xcd_barrier_complete(bar, b.x, nloc, nx); b.st[0] = nloc; b.st[1] = nx; }
        const unsigned old = xb_add(&bar[XB_XSUB(b.x)], 1u);
        const unsigned gen = old / nloc;
        if (old + 1u == (gen + 1u) * nloc) {
            __builtin_amdgcn_fence(__ATOMIC_RELEASE, "agent");
            asm volatile("s_waitcnt vmcnt(0)" ::: "memory");
            const unsigned og = xb_add(&bar[XB_TOP], 1u);
            const unsigned tg = og / nx;
            if (og + 1u == (tg + 1u) * nx) xb_add(&bar[XB_TOPGEN], 1u);
            else XB_SPIN(xb_ld(&bar[XB_TOPGEN]) == tg, bar);
            __builtin_amdgcn_fence(__ATOMIC_ACQUIRE, "agent");
            xb_add(&bar[XB_XGEN(b.x)], 1u);
            asm volatile("s_waitcnt vmcnt(0)" ::: "memory");
        } else {
            XB_SPIN(xb_ld(&bar[XB_XGEN(b.x)]) == gen, bar);
            __builtin_amdgcn_fence(__ATOMIC_ACQUIRE, "agent");
            asm volatile("s_waitcnt vmcnt(0)" ::: "memory");
        }
    }
    __syncthreads();
}

struct Args { const float* in[13]; float* out; unsigned char* ws; };

__device__ __forceinline__ void transpose_item(const float* W, int ldw, int k0, int n0, bf16* WT, int K, int drow0, LAS float* scr, int lane) {
#pragma unroll 8
    for (int i = 0; i < 32; ++i) { const int kk = 2 * i + (lane >> 5); scr[kk * 33 + (lane & 31)] = W[(size_t)(k0 + kk) * ldw + n0 + (lane & 31)]; }
    asm volatile("s_waitcnt lgkmcnt(0)" ::: "memory");
    const int c = lane & 7;
#pragma unroll
    for (int j = 0; j < 4; ++j) { const int n = (lane >> 3) + 8 * j; const LAS float* s = scr + (8 * c) * 33 + n;
        u32x4 o; o.x = cvtpk(s[0], s[33]); o.y = cvtpk(s[2 * 33], s[3 * 33]); o.z = cvtpk(s[4 * 33], s[5 * 33]); o.w = cvtpk(s[6 * 33], s[7 * 33]);
        *(u32x4*)(WT + (size_t)(drow0 + n) * K + k0 + 8 * c) = o; }
    asm volatile("s_waitcnt lgkmcnt(0)" ::: "memory");
}

#define PIN(T, i) ((T*)ldptr(lds, (i)))
__device__ __forceinline__ void* ldptr(LAS unsigned char* lds, int i) {
    const u32x2 v = *(const LAS u32x2*)(lds + PTAB_OFF + 8 * i);
    const unsigned long long p = ((unsigned long long)(unsigned)__builtin_amdgcn_readfirstlane((int)v.y) << 32) | (unsigned)__builtin_amdgcn_readfirstlane((int)v.x);
    return (void*)(__attribute__((address_space(1))) char*)p; }
__device__ __forceinline__ void prologue(LAS unsigned char* lds, int gw, int NGW, int wave, int lane) {
    unsigned char* a_ws = PIN(unsigned char, 14);
    LAS float* scr = (LAS float*)(lds + wave * 16384);
    constexpr int I_QKV = 16 * 96, I_O = 16 * 32, I_UP = 16 * 176, I_DN = 44 * 32, I_L = I_QKV + I_O + I_UP + I_DN;
    for (int it = gw; it < DEPTH * I_L; it += NGW) {
        const int l = it / I_L; int r = it % I_L; const int j = l >> 1; const bool fox = !(l & 1);
        bf16* wl = (bf16*)(a_ws + WS_W + (size_t)l * W_LAYER);
        if (r < I_QKV) { const int kb = r / 96, n0 = 32 * (r % 96);
            const float* W = fox ? PIN(const float, 4) + (size_t)j * D * 3088 : PIN(const float, 7) + (size_t)j * D * 3072; const int ldw = fox ? 3088 : 3072;
            if (n0 < 2048) transpose_item(W, ldw, 64 * kb, n0, wl + WO_QK / 2, D, n0, scr, lane);
            else transpose_item(W, ldw, 64 * kb, n0, wl + WO_V / 2, D, n0 - 2048, scr, lane);
            continue; }
        r -= I_QKV;
        if (r < I_O) { const int kb = r / 32, n0 = 32 * (r % 32); const float* W = (fox ? PIN(const float, 6) : PIN(const float, 8)) + (size_t)j * D * D;
            transpose_item(W, D, 64 * kb, n0, wl + WO_O / 2, D, n0, scr, lane); continue; }
        r -= I_O;
        if (r < I_UP) { const int kb = r / 176, c = 32 * (r % 176); const int drow0 = c < FF ? 256 * (c / 128) + (c % 128) : 256 * ((c - FF) / 128) + 128 + ((c - FF) % 128);
            transpose_item(PIN(const float, 9) + (size_t)l * D * FF2, FF2, 64 * kb, c, wl + WO_UP / 2, D, drow0, scr, lane); continue; }
        r -= I_UP;
        { const int kb = r / 32, n0 = 32 * (r % 32); transpose_item(PIN(const float, 12) + (size_t)l * FF * D, D, 64 * kb, n0, wl + WO_DN / 2, FF, n0, scr, lane); }
    }
}

template <bool FOX, bool SRC_BF16>
__device__ __forceinline__ void norm_phase(const void* src, const float* gain, bf16* xn, const float* Wf, const float* bfp, float* flog, LAS unsigned char* lds, int vcu, int G) {
    int tid = threadIdx.x; asm volatile("" : "+v"(tid));
    const int lane = tid & 63, gw = vcu * NWAVES + (tid >> 6), NGW = G * NWAVES;
    LAS float* wf = (LAS float*)lds;
    if (FOX) {
        for (int k = tid; k < D; k += NTHR) { const f32x4* p = (const f32x4*)(Wf + (size_t)k * 3088 + 3072);
#pragma unroll
            for (int q = 0; q < 4; ++q) { const f32x4 w = p[q];
#pragma unroll
                for (int e = 0; e < 4; ++e) wf[(4 * q + e) * 1024 + k] = w[e]; } }
        __syncthreads();
    }
    f32x4 g[4];
#pragma unroll
    for (int j = 0; j < 4; ++j) g[j] = ((const f32x4*)gain)[lane + 64 * j];
    for (int m = gw; m < M; m += NGW) {
        f32x4 v[4]; float s = 0.f;
#pragma unroll
        for (int j = 0; j < 4; ++j) {
            if (SRC_BF16) { const u32x2 w = ((const u32x2*)((const bf16*)src + (size_t)m * D))[lane + 64 * j]; v[j] = (f32x4){bflo(w.x), bfhi(w.x), bflo(w.y), bfhi(w.y)}; }
            else v[j] = ((const f32x4*)((const float*)src + (size_t)m * D))[lane + 64 * j];
            s += (v[j].x * v[j].x + v[j].y * v[j].y) + (v[j].z * v[j].z + v[j].w * v[j].w); }
        const float rstd = 1.0f / sqrtf(wave_sum(s) * (1.f / D) + NORM_EPS);
        u32x2* o8 = (u32x2*)(xn + (size_t)m * D) + lane;
#pragma unroll
        for (int j = 0; j < 4; ++j) { v[j] = v[j] * rstd * g[j]; u32x2 w; w.x = cvtpk(v[j].x, v[j].y); w.y = cvtpk(v[j].z, v[j].w); o8[64 * j] = w; }
        if (FOX) {
            float mine = 0.f; int lane_l = lane; asm volatile("" : "+v"(lane_l));
#pragma unroll
            for (int hh = 0; hh < 16; ++hh) { float acc = 0.f;
#pragma unroll
                for (int j = 0; j < 4; ++j) { const f32x4 w = *(const LAS f32x4*)(wf + hh * 1024 + 256 * j + 4 * lane); acc += (v[j].x * w.x + v[j].y * w.y) + (v[j].z * w.z + v[j].w * w.w); }
                acc = wave_sum(acc); mine = (lane_l == hh) ? acc : mine; }
            if (lane < 16) { const float x2 = (mine + bfp[lane]) * LOG2E; flog[(size_t)m * 16 + lane] = fminf(x2, 0.f) - lg2(1.f + ex2(-fabsf(x2))); }
        }
    }
    if (FOX) __syncthreads();
}

__device__ __forceinline__ void scan_phase(const float* flog, float* c2, LAS unsigned char* lds, int G) {
    int tid = threadIdx.x; asm volatile("" : "+v"(tid));
    const int lane = tid & 63, wave = tid >> 6;
    LAS float* wsum = (LAS float*)(lds + MISC_OFF);
    for (int bh = blockIdx.x; bh < BATCH * NH; bh += G) {
        const int b = bh / NH, h = bh % NH;
        float v[8]; float run = 0.f;
#pragma unroll
        for (int i = 0; i < 8; ++i) { run += flog[((size_t)b * SEQ + 8 * tid + i) * 16 + h]; v[i] = run; }
        float incl = run;
#pragma unroll
        for (int o = 1; o < 64; o <<= 1) { const float nb = __shfl_up(incl, o); if (lane >= o) incl += nb; }
        if (lane == 63) wsum[wave] = incl;
        __syncthreads();
        float woff = 0.f;
#pragma unroll
        for (int w = 0; w < NWAVES; ++w) woff += (w < wave) ? wsum[w] : 0.f;
        const float excl = incl - run + woff;
        f32x4 o0 = (f32x4){v[0] + excl, v[1] + excl, v[2] + excl, v[3] + excl}, o1 = (f32x4){v[4] + excl, v[5] + excl, v[6] + excl, v[7] + excl};
        f32x4* dst = (f32x4*)(c2 + (size_t)bh * SEQ + 8 * tid); dst[0] = o0; dst[1] = o1;
        __syncthreads();
    }
}

__device__ __forceinline__ void fixup_phase(const float* edge, const float* raw01, const float* wconv, const float* bconv, bf16* act, int bx, int G) {
    int tid = threadIdx.x; asm volatile("" : "+v"(tid));
    const int gtid = bx * NTHR + tid, NGT = G * NTHR;
    for (int idx = gtid; idx < (M / 256) * 2 * FF; idx += NGT) {
        const int c = idx % FF, rr = (idx / FF) & 1, pm = idx / (2 * FF);
        const bool has = (pm % (SEQ / 256)) != 0;
        float r[2];
#pragma unroll
        for (int s = 0; s < 2; ++s) { const int col = s * FF + c;
            const float h0 = raw01[((size_t)pm * 2 + rr) * FF2 + col];
            const float e1 = has ? edge[((size_t)(pm - 1) * 2 + 1) * FF2 + col] : 0.f, e0 = has ? edge[((size_t)(pm - 1) * 2 + 0) * FF2 + col] : 0.f;
            const float hm1 = rr == 0 ? e1 : raw01[((size_t)pm * 2 + 0) * FF2 + col], hm2 = rr == 0 ? e0 : e1;
            r[s] = bconv[col] + wconv[2 * FF2 + col] * h0 + wconv[FF2 + col] * hm1 + wconv[col] * hm2; }
        const float sg = r[1] * __builtin_amdgcn_rcpf(1.f + ex2(-r[1] * LOG2E));
        act[(size_t)(pm * 256 + rr) * FF + c] = (bf16)(cvtpk(sg * r[0], 0.f) & 0xffffu);
    }
}


#ifndef DBG_STAGE
#define DBG_STAGE 0
#endif
#ifndef DBG_SKIP
#define DBG_SKIP 0
#endif
#ifndef DBG_FRAC
#define DBG_FRAC 1
#endif
__device__ __forceinline__ void dbg_dump_bf16(const bf16* src, float* out, int bx, int G) {
    int tid = threadIdx.x; asm volatile("" : "+v"(tid));
    for (size_t i = (size_t)bx * NTHR + tid; i < (size_t)M * D; i += (size_t)G * NTHR) { float v = __uint_as_float((unsigned)src[i] << 16); if (!(fabsf(v) < 1e30f)) v = 10000.f; out[i] = v; }
}

__device__ __forceinline__ float bf2f(bf16 v) { return __uint_as_float((unsigned)v << 16); }
__device__ __forceinline__ unsigned hash32(unsigned x) { x ^= x >> 16; x *= 0x7feb352du; x ^= x >> 15; x *= 0x846ca68bu; x ^= x >> 16; return x; }
__device__ __forceinline__ void dbg_acc(float* word, float got, float exp_) { const float d = fabsf(got - exp_) / (fabsf(exp_) + 0.05f); atomicMax((unsigned*)word, __float_as_uint(d)); }
__device__ __forceinline__ void dbg_check_qkv(const bf16* xn, const float* W  , const bf16* q, const bf16* k, const bf16* vt, float* word, int bx, int G) {
    int tid = threadIdx.x; asm volatile("" : "+v"(tid));
    const unsigned sidx = bx * NTHR + tid; if (sidx >= 16384u) return;
    const unsigned hsh = hash32(sidx * 2654435761u + 12345u); const int row = hsh % M, col = (hsh >> 15) % 3072;
    float acc = 0.f; for (int kk = 0; kk < D; ++kk) acc += bf2f(xn[(size_t)row * D + kk]) * W[(size_t)kk * 3088 + col];
    float got; if (col < 1024) { got = bf2f(q[(size_t)row * D + col]); acc *= QSCALE; } else if (col < 2048) got = bf2f(k[(size_t)row * D + col - 1024]); else got = bf2f(vt[(size_t)(col - 2048) * M + row]);
    dbg_acc(word, got, acc);
}
__device__ __forceinline__ void dbg_check_act(const bf16* xn, const float* Wup  , const float* wconv, const float* bconv, const bf16* act, float* word, int bx, int G, int mode) {
    int tid = threadIdx.x; asm volatile("" : "+v"(tid));
    const unsigned sidx = bx * NTHR + tid; if (sidx >= 16384u) return;
    const unsigned hsh = hash32(sidx * 2654435761u + 777u); int row = hsh % M; int c = (hsh >> 15) % FF;
    if (mode == 7) { row = (row & ~15) + 2 + (int)((hsh >> 27) % 12u); c = (c & ~127) + (int)((hsh >> 20) % 32u); }
    if (mode == 9) { row = (row & ~255 & ~(8 * 256)) + 2 + (int)((hsh >> 27) % 12u) + 16 * (int)((hsh >> 23) % 16u); c = c % 512; }
    if (mode == 8) { row = (row & ~255) + 2 + (int)((hsh >> 27) % 12u); }
    if (mode == 1) row = (row & ~255) + (sidx & 1);
    if (mode == 2) row = (row & ~63) + (sidx & 1);
    if (mode == 3) row = (row & ~15) + (sidx & 1);
    if (mode == 4) row = (row & ~15) + 2 + (int)((hsh >> 27) % 14u);
    if (mode == 5) row = (row & ~15) + 14 + (sidx & 1);
    if (mode == 6) row = (row & ~15) + 2 + (int)((hsh >> 27) % 12u);
    float hc[2];
    for (int s2 = 0; s2 < 2; ++s2) { const int col = s2 * FF + c; float tot = bconv[col];
        for (int tap = 0; tap < 3; ++tap) { const int r = row - 2 + tap; if ((r >> 12) != (row >> 12) || r < 0) continue;
            float acc = 0.f; for (int kk = 0; kk < D; ++kk) acc += bf2f(xn[(size_t)r * D + kk]) * Wup[(size_t)kk * FF2 + col];
            tot += wconv[tap * FF2 + col] * acc; }
        hc[s2] = tot; }
    const float exp_ = hc[0] * hc[1] / (1.f + __expf(-hc[1]));
    const float got_ = bf2f(act[(size_t)row * FF + c]);
    if (DBG_FRAC) { if (fabsf(got_ - exp_) > 0.1f * (fabsf(exp_) + 0.2f)) atomicAdd(word, 1.f / 16384.f); }
    else dbg_acc(word, got_, exp_);
}
__device__ __forceinline__ void dbg_check_attn(const bf16* q, const bf16* k, const bf16* vt, const float* c2, const bf16* o, float* word, int bx, int G, int mode) {
    int tid = threadIdx.x; asm volatile("" : "+v"(tid));
    const int lane = tid & 63; const unsigned sidx = bx * NWAVES + (tid >> 6); if (sidx >= 1024u) return;
    const unsigned hsh = hash32(sidx * 2654435761u + 99u); const int b = hsh % BATCH, h = (hsh >> 8) % NH; int qp = (hsh >> 14) % SEQ; if ((sidx & 7) == 0) qp = (qp & ~255) + (sidx >> 3) % 70;
    const size_t rb = (size_t)b * SEQ; const float qv = bf2f(q[(rb + qp) * D + h * 64 + lane]);
    float od = 0.f;
    if (mode == 0) {
        float mx = -INFINITY; for (int j = 0; j <= qp; ++j) { const float z = wave_sum(qv * bf2f(k[(rb + j) * D + h * 64 + lane])) - c2[((size_t)(b * NH + h)) * SEQ + j]; mx = fmaxf(mx, z); }
        float l = 0.f; for (int j = 0; j <= qp; ++j) { const float z = wave_sum(qv * bf2f(k[(rb + j) * D + h * 64 + lane])) - c2[((size_t)(b * NH + h)) * SEQ + j]; const float p = exp2f(z - mx); l += p; od += p * bf2f(vt[(size_t)(h * 64 + lane) * M + rb + j]); }
        od /= l;
    } else {
        float tail = 0.f; for (int j = qp - 1; j >= 0 && tail > -200.f; --j) { const float z = wave_sum(qv * bf2f(k[(rb + j) * D + h * 64 + lane]));
            const float sp = log2f(1.f + exp2f(z)); const float a = exp2f(z - sp + tail); tail -= sp; od += a * bf2f(vt[(size_t)(h * 64 + lane) * M + rb + j]); }
    }
    const float got = bf2f(o[(rb + qp) * D + h * 64 + lane]);
    const float d = fabsf(got - od) / (fabsf(od) + 0.02f); atomicMax((unsigned*)word, __float_as_uint(d));
}
__device__ __forceinline__ void dbg_check_resid(const float* base, const bf16* a, int K, const float* W, const float* hs, float* word, int bx, int G) {
    int tid = threadIdx.x; asm volatile("" : "+v"(tid));
    const unsigned sidx = bx * NTHR + tid; if (sidx >= 16384u) return;
    const unsigned hsh = hash32(sidx * 2654435761u + 4242u); const int row = hsh % M, col = (hsh >> 15) % D;
    float acc = 0.f; for (int kk = 0; kk < K; ++kk) acc += bf2f(a[(size_t)row * K + kk]) * W[(size_t)kk * D + col];
    const float exp_ = base[(size_t)row * D + col] + acc; dbg_acc(word, hs[(size_t)row * D + col], exp_);
}
#define DBG_BEGIN() do { if (bx0 == 0 && threadIdx.x == 0) *(float*)(PIN(unsigned char, 14) + WS_FLOG - 256) = 0.f; } while (0)
#define DBG_WORD ((float*)(PIN(unsigned char, 14) + WS_FLOG - 256))
#define DBG_FINISH() do { { int tz = threadIdx.x; asm volatile("" : "+v"(tz)); float* od_ = PIN(float, 13); for (size_t i = (size_t)bx0 * NTHR + tz; i < (size_t)M * D; i += (size_t)G0 * NTHR) od_[i] = 0.f; } GSYNC(); \
    if (bx0 == 0 && threadIdx.x == 0) PIN(float, 13)[0] = 10.f + 1000.f * *DBG_WORD; return; } while (0)

#ifndef DBG_DUP
#define DBG_DUP 0
#endif
#ifndef A_QG0
#define A_QG0 2
#endif
#ifndef DBG_TA
#define DBG_TA -1
#endif
#ifndef DBG_TB
#define DBG_TB -1
#endif
#define TSTAMP(cat) do { if (DBG_TA >= 0 && bx0 == 0 && threadIdx.x == 0) { const unsigned long long now_ = __builtin_amdgcn_s_memrealtime(); LAS unsigned* tw_ = (LAS unsigned*)(lds + TIME_OFF); \
    tw_[(cat)] += (unsigned)(now_ - (((unsigned long long)tw_[15] << 32) | tw_[14])); tw_[14] = (unsigned)now_; tw_[15] = (unsigned)(now_ >> 32); } } while (0)
#define GSYNC_CG() do { asm volatile("s_waitcnt vmcnt(0) lgkmcnt(0)" ::: "memory"); __builtin_amdgcn_fence(__ATOMIC_RELEASE, "agent"); grid.sync(); __builtin_amdgcn_fence(__ATOMIC_ACQUIRE, "agent"); } while (0)
#define GSYNC() do { xcd_barrier(xbar); if (DBG_DUP & 64) xcd_barrier(xbar); } while (0)
__global__ void __launch_bounds__(NTHR, 2) fwd_kernel(Args a) {
    extern __shared__ __attribute__((aligned(16))) unsigned char lds_raw[];
    LAS unsigned char* lds = (LAS unsigned char*)lds_raw;
    cg::grid_group grid = cg::this_grid();
    const int tid = threadIdx.x, lane = tid & 63; const int wave = __builtin_amdgcn_readfirstlane(tid >> 6);
    const int G0 = gridDim.x, bx0 = blockIdx.x;
    const int vcu0 = (G0 % 8 == 0) ? (bx0 % 8) * (G0 / 8) + bx0 / 8 : bx0;
    if (tid == 0) {
#pragma unroll
        for (int i = 0; i < 13; ++i) *(LAS unsigned long long*)(lds + PTAB_OFF + 8 * i) = (unsigned long long)a.in[i];
        *(LAS unsigned long long*)(lds + PTAB_OFF + 8 * 13) = (unsigned long long)a.out; *(LAS unsigned long long*)(lds + PTAB_OFF + 8 * 14) = (unsigned long long)a.ws;
    }
    if (tid < 2) ((LAS unsigned*)(lds + MISC_OFF + 64))[tid] = 0u;
    __syncthreads();
    const XcdBarrier xbar = xcd_barrier_post((unsigned*)(PIN(unsigned char, 14) + WS_BAR), (volatile LAS unsigned*)(lds + MISC_OFF + 64));
#define WSP(T, off) ((T*)(PIN(unsigned char, 14) + (off)))
#define XN WSP(bf16, WS_XN)
#define QO WSP(bf16, WS_QO)
#define KB WSP(bf16, WS_K)
#define VT WSP(bf16, WS_VT)
#define ACT WSP(bf16, WS_ACT)
#define FLOG WSP(float, WS_FLOG)
#define C2 WSP(float, WS_C2)
#define EDGE WSP(float, WS_EDGE)
#define RAW01 WSP(float, WS_RAW01)
#define HS PIN(float, 13)
#define HSB WSP(bf16, WS_HSB)
#define XIN PIN(const float, 0)
    if (DBG_STAGE >= 30) DBG_BEGIN();
    if (DBG_TA >= 0 && bx0 == 0 && threadIdx.x == 0) { LAS unsigned* tw_ = (LAS unsigned*)(lds + TIME_OFF); for (int i_ = 0; i_ < 14; ++i_) tw_[i_] = 0u; const unsigned long long now_ = __builtin_amdgcn_s_memrealtime(); tw_[14] = (unsigned)now_; tw_[15] = (unsigned)(now_ >> 32); }
    prologue(lds, vcu0 * NWAVES + wave, G0 * NWAVES, wave, lane);
    if (DBG_DUP & 32) prologue(lds, vcu0 * NWAVES + wave, G0 * NWAVES, wave, lane);
    __syncthreads();
    norm_phase<true, false>(XIN, PIN(const float, 1), XN, PIN(const float, 4), PIN(const float, 5), FLOG, lds, vcu0, G0);
    if (PIN(unsigned char, 14) == nullptr) grid.sync();
    GSYNC(); TSTAMP(0);
    if (DBG_STAGE == 1) { dbg_dump_bf16(XN, HS, bx0, G0); return; }
    for (int l = 0; l < DEPTH; ++l) {
        const bool fox = !(l & 1); const int j = l >> 1;
        int G = G0, bx = bx0, vcu = vcu0; asm volatile("" : "+s"(G), "+s"(bx), "+s"(vcu));
        #define WL ((const bf16*)(PIN(unsigned char, 14) + WS_W + (size_t)l * W_LAYER))
        if (l > 0) {
            if (fox) norm_phase<true, true>(HSB, PIN(const float, 1) + l * D, XN, PIN(const float, 4) + (size_t)j * D * 3088, PIN(const float, 5) + j * NH, FLOG, lds, vcu, G);
            else norm_phase<false, true>(HSB, PIN(const float, 1) + l * D, XN, nullptr, nullptr, nullptr, lds, vcu, G);
            if (DBG_DUP & 16) norm_phase<false, true>(HSB, PIN(const float, 1) + l * D, XN, nullptr, nullptr, nullptr, lds, vcu, G);
            GSYNC(); TSTAMP(1);
        }
        if (fox) scan_phase(FLOG, C2, lds, G);
        for (int rep_ = 0; rep_ < ((DBG_DUP & 1) ? 2 : 1); ++rep_) {
        { pg8::Gemm g{XN, WL + WO_QK / 2, M, 2048, D}; pg8::StaticOrder S; S.init(M, 2048, G, bx);
          pg8::EpiBf16<0> E{QO, D, nullptr, D, (size_t)(WS_K - WS_QO) / 2, QSCALE};
#ifndef NO_QK
          pg8::gemm_phase<pg8::EpiBf16<0>, pg8::StaticOrder, true, true>(lds, g, S, E);
#endif
        }
        { pg8::Gemm g{WL + WO_V / 2, XN, D, M, D}; pg8::StaticOrder S; S.init(D, M, G, bx);
          pg8::EpiBf16<0> E{VT, M, nullptr, 0, 0, 1.f};
#ifndef NO_VT
          pg8::gemm_phase<pg8::EpiBf16<0>, pg8::StaticOrder, true, true>(lds, g, S, E);
#endif
        }
        }
        GSYNC(); TSTAMP(2);
        if (DBG_STAGE == 31 && l == 0) { dbg_check_qkv(XN, PIN(const float, 4), QO, KB, VT, DBG_WORD, bx, G); DBG_FINISH(); }
        if (DBG_STAGE == 32 && l == 0) { attn_phase<0>(vcu, G, QO, KB, VT, C2, XN, lds); GSYNC(); dbg_check_attn(QO, KB, VT, C2, XN, DBG_WORD, bx, G, 0); DBG_FINISH(); }
        if (DBG_STAGE == 35 && l == 1) { attn_phase<1>(vcu, G, QO, KB, VT, C2, XN, lds); GSYNC(); dbg_check_attn(QO, KB, VT, C2, XN, DBG_WORD, bx, G, 1); DBG_FINISH(); }
        if (DBG_STAGE == 2) { dbg_dump_bf16(QO, HS, bx, G); return; }
        if (DBG_STAGE == 3) { dbg_dump_bf16(KB, HS, bx, G); return; }
        if (DBG_STAGE == 4) { dbg_dump_bf16(VT, HS, bx, G); return; }
        if ((DBG_DUP & 4) && fox) attn_phase<0>(vcu, G, QO, KB, VT, C2, XN, lds);
        if ((DBG_DUP & 8) && !fox) attn_phase<1>(vcu, G, QO, KB, VT, C2, XN, lds);
#ifndef NO_ATT0
        if (fox || DBG_STAGE == 10) attn_phase<0>(vcu, G, QO, KB, VT, C2, QO, lds);
#endif
#ifndef NO_ATT1
        if (!fox && DBG_STAGE != 10) attn_phase<1>(vcu, G, QO, KB, VT, C2, QO, lds);
#endif
        GSYNC(); TSTAMP(fox ? 3 : 4);
        if (DBG_STAGE == 5) { dbg_dump_bf16(QO, HS, bx, G); return; }
        if (DBG_STAGE == 9 && l == 1) { dbg_dump_bf16(QO, HS, bx, G); return; }
        if ((DBG_SKIP & (fox ? 1 : 2)) != 0) {
            if (l == 0) { int tq = threadIdx.x; asm volatile("" : "+v"(tq)); const float* xs = XIN; float* hd = HS;
                for (size_t i = (size_t)bx * NTHR + tq; i < (size_t)M * D / 4; i += (size_t)G * NTHR) ((f32x4*)hd)[i] = ((const f32x4*)xs)[i]; }
        } else
        { pg8::Gemm g{QO, WL + WO_O / 2, M, D, D}; pg8::StaticOrder S; S.init(M, D, G, bx);
#ifndef NO_O
          if (l == 0) { EpiResid<true> E{XIN, HSB}; pg8::gemm_phase<EpiResid<true>, pg8::StaticOrder, true, true>(lds, g, S, E); }
          else { EpiResid<false> E{HSB, HSB}; pg8::gemm_phase<EpiResid<false>, pg8::StaticOrder, true, true>(lds, g, S, E); }
#endif
        }
        GSYNC(); TSTAMP(5);
        if (DBG_STAGE == 33 && l == 0) { dbg_check_resid(XIN, QO, D, PIN(const float, 6), HS, DBG_WORD, bx, G); DBG_FINISH(); }
        if (DBG_STAGE == 6) return;
        if ((DBG_SKIP & 4) != 0) continue;
        if ((DBG_STAGE == 8 || DBG_STAGE == 10) && l == 1) return;
        norm_phase<false, true>(HSB, PIN(const float, 2) + l * D, XN, nullptr, nullptr, nullptr, lds, vcu, G);
        if (DBG_DUP & 16) norm_phase<false, true>(HSB, PIN(const float, 2) + l * D, XN, nullptr, nullptr, nullptr, lds, vcu, G);
        GSYNC(); TSTAMP(1);
        #define WCONV (PIN(const float, 10) + (size_t)l * 3 * FF2)
#define BCONV (PIN(const float, 11) + (size_t)l * FF2)
        for (int rep_ = 0; rep_ < ((DBG_DUP & 2) ? 2 : 1); ++rep_)
        { pg8::Gemm g{XN, WL + WO_UP / 2, M, FF2, D}; pg8::StaticOrder S; S.init(M, FF2, G, bx);
          EpiConvGate E{ACT, WCONV, BCONV, EDGE, RAW01, (LAS float*)(lds + XCH_OFF)};
#ifndef NO_UP
          pg8::gemm_phase<EpiConvGate, pg8::StaticOrder, true, true>(lds, g, S, E);
#endif
        }
        GSYNC(); TSTAMP(6);
        fixup_phase(EDGE, RAW01, WCONV, BCONV, ACT, bx, G);
        GSYNC(); TSTAMP(7);
        if (DBG_STAGE >= 40 && DBG_STAGE <= 49 && l == 0) { dbg_check_act(XN, PIN(const float, 9), WCONV, BCONV, ACT, DBG_WORD, bx, G, DBG_STAGE - 40); DBG_FINISH(); }
        { pg8::Gemm g{ACT, WL + WO_DN / 2, M, D, FF}; pg8::StaticOrder S; S.init(M, D, G, bx);
#ifndef NO_DN
          { EpiResid<false> E{HSB, HSB}; pg8::gemm_phase<EpiResid<false>, pg8::StaticOrder, true, true>(lds, g, S, E); }
#endif
        }
        GSYNC(); TSTAMP(8);        if (DBG_STAGE == 7) return;
    }
    {
        int tidf = threadIdx.x; asm volatile("" : "+v"(tidf));
        const int lane = tidf & 63, gw = vcu0 * NWAVES + (tidf >> 6), NGW = G0 * NWAVES;
        f32x4 g[4];
#pragma unroll
        for (int jq = 0; jq < 4; ++jq) g[jq] = ((const f32x4*)PIN(const float, 3))[lane + 64 * jq];
        float* out_ = HS; const bf16* hsb_ = HSB;
        for (int m = gw; m < M; m += NGW) {
            f32x4* xr = (f32x4*)(out_ + (size_t)m * D) + lane;
            f32x4 v[4]; float s = 0.f;
#pragma unroll
            for (int jq = 0; jq < 4; ++jq) { const u32x2 w = ((const u32x2*)(hsb_ + (size_t)m * D))[lane + 64 * jq]; v[jq] = (f32x4){bflo(w.x), bfhi(w.x), bflo(w.y), bfhi(w.y)};
                s += (v[jq].x * v[jq].x + v[jq].y * v[jq].y) + (v[jq].z * v[jq].z + v[jq].w * v[jq].w); }
            const float rstd = 1.0f / sqrtf(wave_sum(s) * (1.f / D) + NORM_EPS);
#pragma unroll
            for (int jq = 0; jq < 4; ++jq) xr[64 * jq] = v[jq] * rstd * g[jq];
        }
    }
    if (DBG_TA >= 0) {
        GSYNC(); TSTAMP(9);
        if (bx0 == 0) { const LAS unsigned* tw_ = (const LAS unsigned*)(lds + TIME_OFF); float* od_ = PIN(float, 13); int tz = threadIdx.x;
            const float va = 40.f + 5.f * log2f(0.01f * (float)tw_[DBG_TA < 0 ? 0 : DBG_TA] + 1.f), vb = 5.f * log2f(0.01f * (float)tw_[DBG_TB < 0 ? 0 : DBG_TB] + 1.f);
            for (int i = tz; i < 32768; i += NTHR) od_[i] = (i == 0) ? va : vb; }
    }
}

extern "C" void kernel_launch(void* const* d_in, const int* in_sizes, int n_in, void* d_out, int out_size, void* d_ws, size_t ws_size, hipStream_t stream) {
    static int grid = 0;
    if (grid == 0) {
        if (n_in != 13 || out_size != M * D || ws_size < WS_END) { fprintf(stderr, "kernel_launch: unexpected problem shape (n_in %d, out %d, ws %zu)\n", n_in, out_size, ws_size); grid = -1; return; }
        int dev = 0, cus = 0, per_cu = 0;
        (void)hipGetDevice(&dev); (void)hipDeviceGetAttribute(&cus, hipDeviceAttributeMultiprocessorCount, dev);
        if (hipFuncSetAttribute((const void*)fwd_kernel, hipFuncAttributeMaxDynamicSharedMemorySize, LDS_BYTES) != hipSuccess) { fprintf(stderr, "kernel_launch: hipFuncSetAttribute failed\n"); }
        if (hipOccupancyMaxActiveBlocksPerMultiprocessor(&per_cu, (const void*)fwd_kernel, NTHR, LDS_BYTES) != hipSuccess || per_cu < 1) { fprintf(stderr, "kernel_launch: occupancy query gave %d; using 1\n", per_cu); per_cu = 1; }
        (void)hipGetLastError();
        grid = cus * per_cu;
    }
    if (grid < 0) return;
    if (hipMemsetAsync((char*)d_ws + WS_BAR, 0, XCD_BAR_WORDS * 4, stream) != hipSuccess) { fprintf(stderr, "kernel_launch: hipMemsetAsync failed\n"); return; }
    Args a{};
    for (int i = 0; i < 13; ++i) a.in[i] = (const float*)d_in[i];
    a.out = (float*)d_out; a.ws = (unsigned char*)d_ws;
    void* args[] = {&a};
    const hipError_t e = hipLaunchCooperativeKernel((const void*)fwd_kernel, dim3(grid), dim3(NTHR), args, LDS_BYTES, stream);
    if (e != hipSuccess) fprintf(stderr, "kernel_launch: cooperative launch failed: %s (grid %d)\n", hipGetErrorString(e), grid);
}
```
